# Optimizing an MI355X kernel written in HIP

```python
import jax
import jax.numpy as jnp
from jax import lax
import numpy as np

D_MODEL = 1024
BATCH = 2
SEQ = 16384
DEPTH = 2

GRID_W = 64
HEAD_DIM = 64
EPS = 1e-6

NA_HEADS = 6
NA_WIN_H = 8
NA_WIN_W = 16
A_WIDTH = NA_HEADS * HEAD_DIM

MLA_HEADS = 6
MLA_Q_RANK = 256
MLA_KV_RANK = 128
MLA_NOPE = 64
MLA_ROPE = 32
MLA_QK = MLA_NOPE + MLA_ROPE
MLA_V = 64
B_WIDTH = MLA_HEADS * MLA_V
ROPE_THETA = 10000.0
Q_BLOCK = 128

CONV_GROUPS = 4
CONV_CH = CONV_GROUPS * HEAD_DIM
CONV_W = 3
C_WIDTH = CONV_CH

D_MIX = A_WIDTH + B_WIDTH + C_WIDTH
IN_SIZES = (A_WIDTH, A_WIDTH, A_WIDTH, MLA_Q_RANK, MLA_KV_RANK, MLA_ROPE, C_WIDTH, C_WIDTH, C_WIDTH)
IN_COLS = sum(IN_SIZES)

N_EXPERTS = 16
EXPERT_FF = 1024
CAPACITY_FACTOR = 2

kernel_name = 'hybrid_natten_mla_shortconv_ec_moe'


def rms_norm(x, g):
    xf = x.astype(jnp.float32)
    y = xf * lax.rsqrt(jnp.mean(xf * xf, axis=-1, keepdims=True) + EPS)
    return (y * g.astype(jnp.float32)).astype(x.dtype)


def rope(x, pos):
    half = x.shape[-1] // 2
    inv = ROPE_THETA ** (-jnp.arange(half, dtype=jnp.float32) / half)
    ang = pos.astype(jnp.float32)[:, None] * inv[None, :]
    cos = jnp.cos(ang)[None, :, None, :]
    sin = jnp.sin(ang)[None, :, None, :]
    xf = x.astype(jnp.float32)
    x1, x2 = xf[..., :half], xf[..., half:]
    return jnp.concatenate([x1 * cos - x2 * sin, x2 * cos + x1 * sin], axis=-1).astype(x.dtype)


def neighbourhood_attention(q, k, v, rpb):
    b, s, h, dh = q.shape
    rows = s // GRID_W
    wh = min(NA_WIN_H, rows)
    ww = NA_WIN_W
    cols = np.arange(GRID_W)
    col_idx = np.clip(cols - ww // 2, 0, GRID_W - ww)[:, None] + np.arange(ww)[None, :]
    col_off = col_idx - cols[:, None] + (NA_WIN_W - 1)
    qg = q.reshape(b, rows, GRID_W, h, dh).transpose(1, 0, 2, 3, 4)
    kg = k.reshape(b, rows, GRID_W, h, dh)
    vg = v.reshape(b, rows, GRID_W, h, dh)
    scale = dh ** -0.5

    def one_row(args):
        r, q_row = args
        r0 = jnp.clip(r - wh // 2, 0, rows - wh)
        k_win = lax.dynamic_slice_in_dim(kg, r0, wh, axis=1)[:, :, col_idx]
        v_win = lax.dynamic_slice_in_dim(vg, r0, wh, axis=1)[:, :, col_idx]
        row_off = r0 + jnp.arange(wh) - r + (NA_WIN_H - 1)
        bias = rpb[:, row_off[:, None, None], col_off[None, :, :]].transpose(0, 2, 1, 3)
        sc = jnp.einsum('bqhd,biqjhd->bhqij', q_row, k_win).astype(jnp.float32) * scale
        sc = sc + bias.astype(jnp.float32)[None]
        p = jax.nn.softmax(sc.reshape(b, h, GRID_W, wh * ww), axis=-1).reshape(sc.shape).astype(v.dtype)
        return jnp.einsum('bhqij,biqjhd->bqhd', p, v_win)

    o = lax.map(one_row, (jnp.arange(rows), qg))
    return o.transpose(1, 0, 2, 3, 4).reshape(b, s, h * dh)


def mla_attention(q, k, v):
    b, s, h, dq = q.shape
    dv = v.shape[-1]
    nblk = s // Q_BLOCK
    scale = dq ** -0.5
    qb = q.reshape(b, nblk, Q_BLOCK, h, dq).transpose(1, 0, 2, 3, 4)

    def one_block(q_blk):
        sc = jnp.einsum('bqhd,bkhd->bhqk', q_blk, k).astype(jnp.float32) * scale
        p = jax.nn.softmax(sc, axis=-1).astype(v.dtype)
        return jnp.einsum('bhqk,bkhd->bqhd', p, v)

    o = lax.map(one_block, qb)
    return o.transpose(1, 0, 2, 3, 4).reshape(b, s, h * dv)


def short_conv_mixer(hc, bc, cc, conv_w):
    u = cc * hc
    y = lax.conv_general_dilated(
        u, conv_w[:, None, :].astype(u.dtype), window_strides=(1,),
        padding=((CONV_W // 2, CONV_W // 2),), dimension_numbers=('NWC', 'WIO', 'NWC'),
        feature_group_count=u.shape[-1])
    return bc * y


def expert_choice_moe(x, w_router, b_router, w_gate, w_up, w_down):
    b, s, d = x.shape
    cap = CAPACITY_FACTOR * s // N_EXPERTS
    logits = jnp.einsum('bsd,de->bse', x, w_router).astype(jnp.float32) + b_router.astype(jnp.float32)
    aff = jax.nn.softmax(logits, axis=-1)
    gate, idx = lax.top_k(aff.transpose(0, 2, 1), cap)
    bidx = jnp.arange(b)[:, None, None]
    xs = x[bidx, idx]
    hid = jax.nn.silu(jnp.einsum('becd,edf->becf', xs, w_gate)) * jnp.einsum('becd,edf->becf', xs, w_up)
    ys = jnp.einsum('becf,efd->becd', hid, w_down) * gate[..., None].astype(x.dtype)
    return jnp.zeros_like(x).at[bidx, idx].add(ys)


def hybrid_layer(x, pos, norm_mix, w_in, q_norm_a, k_norm_a, rpb, cq_norm, w_uq, ckv_norm, w_ukv,
                 q_norm_b, k_norm_b, conv_w, out_norm, w_out, norm_ffn, w_router, b_router,
                 w_gate, w_up, w_down):
    b, s, _ = x.shape
    hn = rms_norm(x, norm_mix)
    proj = jnp.einsum('bsd,dc->bsc', hn, w_in)
    splits = np.cumsum(IN_SIZES)[:-1].tolist()
    qa, ka, va, cq, ckv, kr, hc, bc, cc = jnp.split(proj, splits, axis=-1)

    qa = rms_norm(qa.reshape(b, s, NA_HEADS, HEAD_DIM), q_norm_a)
    ka = rms_norm(ka.reshape(b, s, NA_HEADS, HEAD_DIM), k_norm_a)
    va = va.reshape(b, s, NA_HEADS, HEAD_DIM)
    out_a = neighbourhood_attention(qa, ka, va, rpb)

    qb = jnp.einsum('bsr,rc->bsc', rms_norm(cq, cq_norm), w_uq).reshape(b, s, MLA_HEADS, MLA_QK)
    kv = jnp.einsum('bsr,rc->bsc', rms_norm(ckv, ckv_norm), w_ukv).reshape(b, s, MLA_HEADS, MLA_NOPE + MLA_V)
    kb = jnp.concatenate(
        [kv[..., :MLA_NOPE], jnp.broadcast_to(kr[:, :, None, :], (b, s, MLA_HEADS, MLA_ROPE))], axis=-1)
    vb = kv[..., MLA_NOPE:]
    qb = rms_norm(qb, q_norm_b)
    kb = rms_norm(kb, k_norm_b)
    qb = jnp.concatenate([qb[..., :MLA_NOPE], rope(qb[..., MLA_NOPE:], pos)], axis=-1)
    kb = jnp.concatenate([kb[..., :MLA_NOPE], rope(kb[..., MLA_NOPE:], pos)], axis=-1)
    out_b = mla_attention(qb, kb, vb)

    out_c = short_conv_mixer(hc, bc, cc, conv_w)

    mixed = jnp.concatenate([
        rms_norm(out_a, out_norm[:A_WIDTH]),
        rms_norm(out_b, out_norm[A_WIDTH:A_WIDTH + B_WIDTH]),
        rms_norm(out_c, out_norm[A_WIDTH + B_WIDTH:]),
    ], axis=-1)
    x = x + jnp.einsum('bsc,cd->bsd', mixed, w_out)
    x = x + expert_choice_moe(rms_norm(x, norm_ffn), w_router, b_router, w_gate, w_up, w_down)
    return x


def setup_inputs(seed: int = 0) -> dict:
    key = jax.random.key(seed)
    ks = jax.random.split(key, 22)
    f32 = jnp.float32

    def nrm(k, shape, scale):
        return jax.random.normal(k, shape, f32) * scale

    def gain(k, shape):
        return 1.0 + 0.05 * jax.random.normal(k, shape, f32)

    res_scale = (2 * DEPTH) ** -0.5
    return {
        'x': nrm(ks[0], (BATCH, SEQ, D_MODEL), 1.0),
        'norm_mix': gain(ks[1], (DEPTH, D_MODEL)),
        'w_in': nrm(ks[2], (DEPTH, D_MODEL, IN_COLS), D_MODEL ** -0.5),
        'q_norm_a': gain(ks[3], (DEPTH, HEAD_DIM)),
        'k_norm_a': gain(ks[4], (DEPTH, HEAD_DIM)),
        'rpb': nrm(ks[5], (DEPTH, NA_HEADS, 2 * NA_WIN_H - 1, 2 * NA_WIN_W - 1), 0.1),
        'cq_norm': gain(ks[6], (DEPTH, MLA_Q_RANK)),
        'w_uq': nrm(ks[7], (DEPTH, MLA_Q_RANK, MLA_HEADS * MLA_QK), MLA_Q_RANK ** -0.5),
        'ckv_norm': gain(ks[8], (DEPTH, MLA_KV_RANK)),
        'w_ukv': nrm(ks[9], (DEPTH, MLA_KV_RANK, MLA_HEADS * (MLA_NOPE + MLA_V)), MLA_KV_RANK ** -0.5),
        'q_norm_b': gain(ks[10], (DEPTH, MLA_QK)),
        'k_norm_b': gain(ks[11], (DEPTH, MLA_QK)),
        'conv_w': nrm(ks[12], (DEPTH, CONV_W, CONV_CH), CONV_W ** -0.5),
        'out_norm': gain(ks[13], (DEPTH, D_MIX)),
        'w_out': nrm(ks[14], (DEPTH, D_MIX, D_MODEL), D_MIX ** -0.5 * res_scale),
        'norm_ffn': gain(ks[15], (DEPTH, D_MODEL)),
        'w_router': nrm(ks[16], (DEPTH, D_MODEL, N_EXPERTS), D_MODEL ** -0.5),
        'b_router': nrm(ks[17], (DEPTH, N_EXPERTS), 0.01),
        'w_gate': nrm(ks[18], (DEPTH, N_EXPERTS, D_MODEL, EXPERT_FF), D_MODEL ** -0.5),
        'w_up': nrm(ks[19], (DEPTH, N_EXPERTS, D_MODEL, EXPERT_FF), D_MODEL ** -0.5),
        'w_down': nrm(ks[20], (DEPTH, N_EXPERTS, EXPERT_FF, D_MODEL), EXPERT_FF ** -0.5),
    }


def reference(x, norm_mix, w_in, q_norm_a, k_norm_a, rpb, cq_norm, w_uq, ckv_norm, w_ukv,
              q_norm_b, k_norm_b, conv_w, out_norm, w_out, norm_ffn, w_router, b_router,
              w_gate, w_up, w_down):
    pos = jnp.arange(x.shape[1], dtype=jnp.int32)
    for l in range(DEPTH):
        x = hybrid_layer(x, pos, norm_mix[l], w_in[l], q_norm_a[l], k_norm_a[l], rpb[l], cq_norm[l],
                         w_uq[l], ckv_norm[l], w_ukv[l], q_norm_b[l], k_norm_b[l], conv_w[l],
                         out_norm[l], w_out[l], norm_ffn[l], w_router[l], b_router[l],
                         w_gate[l], w_up[l], w_down[l])
    return x
```

```cpp
#include <hip/hip_runtime.h>
#include <cstdio>
#include <cstdint>

#define LAS __attribute__((address_space(3)))
typedef unsigned short bf16;
typedef float f32x4 __attribute__((ext_vector_type(4)));
typedef float f32x2 __attribute__((ext_vector_type(2)));
typedef unsigned u32x4 __attribute__((ext_vector_type(4)));
typedef unsigned u32x2 __attribute__((ext_vector_type(2)));

constexpr int BATCH = 2, SEQ = 16384, T = BATCH * SEQ, DM = 1024, DEPTH = 2;
constexpr int GRID_W = 64, ROWS = SEQ / GRID_W, HD = 64;
constexpr int NAH = 6, WH = 8, WW = 16, AW = 384;
constexpr int MH = 6, QR = 256, KVR = 128, NOPE = 64, ROPE = 32, DQK = 96, DV = 64, BW = 384;
constexpr int CCH = 256, INC = 2336;
constexpr int NE = 16, FF = 1024, CAP = 2048;
constexpr float EPS = 1e-6f;
constexpr int C_QA = 0, C_KA = 384, C_VA = 768, C_CQ = 1152, C_CKV = 1408, C_KR = 1536, C_HC = 1568, C_BC = 1824, C_CC = 2080;
constexpr float QSCALE = 0.10206207261596575f * 1.4426950408889634f;

enum { I_X = 0, I_NORM_MIX, I_W_IN, I_QNA, I_KNA, I_RPB, I_CQN, I_WUQ, I_CKVN, I_WUKV, I_QNB, I_KNB, I_CONVW, I_OUTN, I_WOUT, I_NFFN, I_WR, I_BR, I_WG, I_WU, I_WD, N_IN };

constexpr size_t MiB = 1u << 20;
constexpr size_t WS_CTL = 0, CTL_ZERO_BYTES = 65536;
constexpr size_t WS_ROPE = 2 * MiB;
constexpr size_t WS_WSMALL = 4 * MiB;
constexpr size_t WS_WEGU = 20 * MiB, WS_WED = 84 * MiB;
constexpr size_t WS_HN = 116 * MiB;
constexpr size_t WS_PROJ = 180 * MiB, WS_HID = 180 * MiB;
constexpr size_t WS_QB = 326 * MiB, WS_KB = 362 * MiB, WS_KV = 398 * MiB, WS_OA = 446 * MiB, WS_OB = 470 * MiB;
constexpr size_t WS_YS = 326 * MiB;
constexpr size_t WS_AFF = 494 * MiB, WS_IDX = 496 * MiB, WS_INV = 497 * MiB, WS_END = 500 * MiB;

constexpr int LDS_BYTES = 147456;
constexpr int LDS_CTL_OFF = 131072;

__device__ __forceinline__ float bf2f(bf16 v) { return __uint_as_float((unsigned)v << 16); }
__device__ __forceinline__ float bflo(unsigned u) { return __uint_as_float(u << 16); }
__device__ __forceinline__ float bfhi(unsigned u) { return __uint_as_float(u & 0xffff0000u); }
__device__ __forceinline__ unsigned f2bf(float f) { unsigned u = __float_as_uint(f); return (u + 0x7fffu + ((u >> 16) & 1u)) >> 16; }
__device__ __forceinline__ unsigned pk2(float lo, float hi) { return f2bf(lo) | (f2bf(hi) << 16); }
__device__ __forceinline__ float wave_sum(float v) {
#pragma unroll
    for (int o = 1; o < 64; o <<= 1) v += __shfl_xor(v, o);
    return v;
}

#define XB_TMO      128
#define XB_XCNT(j)  (256  + 64 * (j))
#define XB_XSUB(j)  (1280 + 64 * (j))
#define XB_XGEN(j)  (2304 + 64 * (j))
#define XB_TOP      3328
#define XB_TOPGEN   3392
#define XCD_BAR_WORDS 3456
#define XB_SPIN_CAP (1u << 22)

__device__ __forceinline__ unsigned xb_ld(unsigned* p)              { return __hip_atomic_load(p, __ATOMIC_RELAXED, __HIP_MEMORY_SCOPE_AGENT); }
__device__ __forceinline__ unsigned xb_add(unsigned* p, unsigned v) { return __hip_atomic_fetch_add(p, v, __ATOMIC_RELAXED, __HIP_MEMORY_SCOPE_AGENT); }
__device__ __forceinline__ unsigned xb_xcc_id() { return (unsigned)__builtin_amdgcn_s_getreg((3 << 11) | 20) & 0xFu; }
#define XB_SPIN(cond, bar) do { unsigned _sp = 0; while (cond) { __builtin_amdgcn_s_sleep(1); \
    if ((++_sp & 255u) == 0u) { if (xb_ld(&(bar)[XB_TMO])) break; if (_sp > XB_SPIN_CAP) { atomicAdd(&(bar)[XB_TMO], 1u); break; } } } } while (0)

struct XcdBarrier { unsigned* bar; unsigned x; volatile LAS unsigned* st; };

__device__ __forceinline__ XcdBarrier xcd_barrier_post(unsigned* bar, volatile LAS unsigned* st) {
    XcdBarrier b; b.bar = bar; b.x = xb_xcc_id(); b.st = st;
    if (threadIdx.x == 0) (void)xb_add(&bar[XB_XCNT(b.x)], 1u);
    return b;
}
__device__ __forceinline__ void xcd_barrier_complete(unsigned* bar, unsigned x, unsigned& nloc, unsigned& nx) {
    const unsigned G = gridDim.x * gridDim.y * gridDim.z;
    unsigned sum, cnt, mine, sp = 0u;
    for (;;) {
        sum = 0u; cnt = 0u; mine = 0u;
#pragma unroll
        for (unsigned j = 0; j < 16; ++j) { const unsigned c = xb_ld(&bar[XB_XCNT(j)]); sum += c; cnt += (c > 0u) ? 1u : 0u; mine = (j == x) ? c : mine; }
        if (sum == G) break;
        __builtin_amdgcn_s_sleep(1);
        if ((++sp & 255u) == 0u) { if (xb_ld(&bar[XB_TMO])) break; if (sp > XB_SPIN_CAP) { atomicAdd(&bar[XB_TMO], 1u); break; } }
    }
    nloc = mine > 0u ? mine : 1u; nx = cnt > 0u ? cnt : 1u;
}
__device__ __forceinline__ void xcd_barrier(const XcdBarrier& b) {
    asm volatile("s_waitcnt vmcnt(0)" ::: "memory");
    __syncthreads();
    if (threadIdx.x == 0) {
        unsigned* bar = b.bar;
        __builtin_amdgcn_s_waitcnt(0);
        unsigned nloc = b.st[0], nx = b.st[1];
        if (nloc == 0u) { xcd_barrier_complete(bar, b.x, nloc, nx); b.st[0] = nloc; b.st[1] = nx; }
        const unsigned old = xb_add(&bar[XB_XSUB(b.x)], 1u);
        const unsigned gen = old / nloc;
        if (old + 1u == (gen + 1u) * nloc) {
            __builtin_amdgcn_fence(__ATOMIC_RELEASE, "agent");
            asm volatile("s_waitcnt vmcnt(0)" ::: "memory");
            const unsigned og = xb_add(&bar[XB_TOP], 1u);
            const unsigned tg = og / nx;
            if (og + 1u == (tg + 1u) * nx) xb_add(&bar[XB_TOPGEN], 1u);
            else XB_SPIN(xb_ld(&bar[XB_TOPGEN]) == tg, bar);
            __builtin_amdgcn_fence(__ATOMIC_ACQUIRE, "agent");
            xb_add(&bar[XB_XGEN(b.x)], 1u);
            asm volatile("s_waitcnt vmcnt(0)" ::: "memory");
        } else {
            XB_SPIN(xb_ld(&bar[XB_XGEN(b.x)]) == gen, bar);
            __builtin_amdgcn_fence(__ATOMIC_ACQUIRE, "agent");
            asm volatile("s_waitcnt vmcnt(0)" ::: "memory");
        }
    }
    __syncthreads();
}

struct Params { const float* in[N_IN]; float* out; unsigned char* ws; };

struct Ctx {
    int tid, lane, wave, G, bid;
    int gw, ngw;
    unsigned char* lds;
};
__device__ __forceinline__ Ctx launder(const Ctx& c0) {
    Ctx c = c0; int tid = c0.tid, bid = c0.bid, G = c0.G;
    asm volatile("" : "+v"(tid)); asm volatile("" : "+s"(bid)); asm volatile("" : "+s"(G));
    c.tid = tid; c.lane = tid & 63; c.wave = __builtin_amdgcn_readfirstlane(tid >> 6); c.bid = bid; c.G = G;
    c.gw = bid * 8 + c.wave; c.ngw = G * 8;
    return c;
}

__constant__ double ROPE_C[16] = {0.5403023058681398, 0.8460091102817079, 0.9504152802551828, 0.9842302344700946, 0.9950041652780258, 0.9984192777926645, 0.9995000416652778, 0.9998418902836144,
                                  0.9999500004166653, 0.9999841886533658, 0.9999950000041666, 0.9999984188615866, 0.9999995000000417, 0.9999998418861211, 0.9999999500000004, 0.9999999841886117};
__constant__ double ROPE_S[16] = {0.8414709848078965, 0.5331684399140229, 0.31098359290718575, 0.17689218624615005, 0.09983341664682815, 0.05620449921469249, 0.03161750640243371, 0.01778185687966613,
                                  0.009999833334166664, 0.005623383613960186, 0.0031622723897082477, 0.0017782784728035289, 0.0009999998333333417, 0.0005623412955523594, 0.0003162277607463752, 0.00017782794006665674};

__device__ __forceinline__ void phase_rope_table(const Params& p, const Ctx& c0) {
    const Ctx c = launder(c0);
    f32x2* tab = (f32x2*)(p.ws + WS_ROPE);
    for (int it = c.bid * 512 + c.tid; it < SEQ * 16; it += c.G * 512) {
        const int s = it >> 4, i = it & 15;
        double bc = ROPE_C[i], bs = ROPE_S[i], rc = 1.0, rs = 0.0;
#pragma unroll
        for (int b = 0; b < 14; ++b) {
            if ((s >> b) & 1) { const double nc = rc * bc - rs * bs, ns = rc * bs + rs * bc; rc = nc; rs = ns; }
            const double c2 = bc * bc - bs * bs, s2 = 2.0 * bc * bs; bc = c2; bs = s2;
        }
        tab[it] = (f32x2){(float)rc, (float)rs};
    }
}

__device__ __forceinline__ void row_load(const float* row, int lane, f32x4 (&v)[4]) {
#pragma unroll
    for (int j = 0; j < 4; ++j) v[j] = *(const f32x4*)(row + 4 * (lane + 64 * j));
}
__device__ __forceinline__ float row_rstd(const f32x4 (&v)[4]) {
    float s = 0.f;
#pragma unroll
    for (int j = 0; j < 4; ++j) s += (v[j].x * v[j].x + v[j].y * v[j].y) + (v[j].z * v[j].z + v[j].w * v[j].w);
    return rsqrtf(wave_sum(s) * (1.f / DM) + EPS);
}
__device__ __forceinline__ void row_norm_store(const f32x4 (&v)[4], float rstd, const float* g, bf16* orow, int lane, f32x4 (&xn)[4]) {
#pragma unroll
    for (int j = 0; j < 4; ++j) {
        const f32x4 gg = *(const f32x4*)(g + 4 * (lane + 64 * j));
        xn[j] = v[j] * rstd * gg;
        u32x2 w; w.x = pk2(xn[j].x, xn[j].y); w.y = pk2(xn[j].z, xn[j].w);
        *(u32x2*)(orow + 4 * (lane + 64 * j)) = w;
    }
}

__device__ __forceinline__ void phase_norm0(const Params& p, const Ctx& c0) {
    const Ctx c = launder(c0);
    const float* x = p.in[I_X]; const float* g = p.in[I_NORM_MIX]; bf16* HN = (bf16*)(p.ws + WS_HN);
    for (int t = c.gw; t < T; t += c.ngw) {
        f32x4 v[4], xn[4]; row_load(x + (size_t)t * DM, c.lane, v);
        const float rstd = row_rstd(v);
        row_norm_store(v, rstd, g, HN + (size_t)t * DM, c.lane, xn);
    }
}

struct NGemm { const bf16* A; int lda; const int* rows; int row_base; const float* W; const float* W2; int ldb; int N; int K; };
template <bool DUAL, class Epi>
__device__ __forceinline__ void ngemm_tile(const NGemm& g, int tm, int tn, unsigned char* lds, const Epi& epi) {
    constexpr int RT = DUAL ? 4 : 8, TM = 16 * RT;
    float* As = (float*)lds;
    float* Bs = As + 16 * 128;
    float* Bs2 = Bs + 16 * 128;
    const int tid = threadIdx.x, ty = tid >> 5, tx = tid & 31;
    float acc[RT][4], acc2[RT][4];
#pragma unroll
    for (int i = 0; i < RT; ++i)
#pragma unroll
        for (int j = 0; j < 4; ++j) { acc[i][j] = 0.f; acc2[i][j] = 0.f; }
    const int ar = DUAL ? (tid >> 3) : (tid >> 2), ak = DUAL ? 2 * (tid & 7) : 4 * (tid & 3);
    const int arow = tm * TM + ar;
    const long asrc = (long)g.row_base + (g.rows ? g.rows[arow] : arow);
    const bf16* ap = g.A + (size_t)asrc * g.lda + ak;
    const int bk = tid >> 5, bn = tn * 128 + (tid & 31) * 4;
    const bool bok = bn < g.N;
    for (int k0 = 0; k0 < g.K; k0 += 16) {
        u32x2 av = (u32x2){0u, 0u};
        if (DUAL) av.x = *(const unsigned*)(ap + k0); else av = *(const u32x2*)(ap + k0);
        f32x4 bv = (f32x4){0.f, 0.f, 0.f, 0.f}, bv2 = (f32x4){0.f, 0.f, 0.f, 0.f};
        if (bok) { bv = *(const f32x4*)(g.W + (size_t)(k0 + bk) * g.ldb + bn); if (DUAL) bv2 = *(const f32x4*)(g.W2 + (size_t)(k0 + bk) * g.ldb + bn); }
        __syncthreads();
        As[(ak + 0) * TM + ar] = bflo(av.x); As[(ak + 1) * TM + ar] = bfhi(av.x);
        if (!DUAL) { As[(ak + 2) * TM + ar] = bflo(av.y); As[(ak + 3) * TM + ar] = bfhi(av.y); }
        *(f32x4*)(Bs + bk * 128 + (tid & 31) * 4) = bv;
        if (DUAL) *(f32x4*)(Bs2 + bk * 128 + (tid & 31) * 4) = bv2;
        __syncthreads();
#pragma unroll
        for (int kk = 0; kk < 16; ++kk) {
            float a[RT];
#pragma unroll
            for (int q = 0; q < RT / 4; ++q) { const f32x4 a4 = *(const f32x4*)(As + kk * TM + ty * RT + 4 * q); a[4 * q] = a4.x; a[4 * q + 1] = a4.y; a[4 * q + 2] = a4.z; a[4 * q + 3] = a4.w; }
            const f32x4 b = *(const f32x4*)(Bs + kk * 128 + tx * 4);
#pragma unroll
            for (int i = 0; i < RT; ++i) { acc[i][0] += a[i] * b.x; acc[i][1] += a[i] * b.y; acc[i][2] += a[i] * b.z; acc[i][3] += a[i] * b.w; }
            if (DUAL) {
                const f32x4 b2 = *(const f32x4*)(Bs2 + kk * 128 + tx * 4);
#pragma unroll
                for (int i = 0; i < RT; ++i) { acc2[i][0] += a[i] * b2.x; acc2[i][1] += a[i] * b2.y; acc2[i][2] += a[i] * b2.z; acc2[i][3] += a[i] * b2.w; }
            }
        }
    }
    const int col0 = tn * 128 + tx * 4;
    if (col0 < g.N) {
#pragma unroll
        for (int i = 0; i < RT; ++i) epi(tm * TM + ty * RT + i, col0, acc[i], acc2[i]);
    }
    __syncthreads();
}

__device__ __forceinline__ void phase_inproj(const Params& p, const Ctx& c0, int l) {
    const Ctx c = launder(c0);
    NGemm g{(const bf16*)(p.ws + WS_HN), DM, nullptr, 0, p.in[I_W_IN] + (size_t)l * DM * INC, nullptr, INC, INC, DM};
    bf16* PROJ = (bf16*)(p.ws + WS_PROJ);
    const int tn_n = (INC + 127) / 128, ntile = (T / 128) * tn_n;
    for (int tt = c.bid; tt < ntile; tt += c.G) {
        const int tm = tt / tn_n, tn = tt % tn_n;
        ngemm_tile<false>(g, tm, tn, c.lds, [=](int r, int col, const float (&v)[4], const float (&)[4]) {
            u32x2 w; w.x = pk2(v[0], v[1]); w.y = pk2(v[2], v[3]); *(u32x2*)(PROJ + (size_t)r * INC + col) = w; });
    }
}

__device__ __forceinline__ void phase_c1(const Params& p, const Ctx& c0, int l) {
    const Ctx c = launder(c0);
    bf16* PROJ = (bf16*)(p.ws + WS_PROJ); bf16* MIX = (bf16*)(p.ws + WS_HN);
    const float* qna = p.in[I_QNA] + l * HD; const float* kna = p.in[I_KNA] + l * HD;
    const float* cqn = p.in[I_CQN] + l * QR; const float* ckvn = p.in[I_CKVN] + l * KVR;
    const float* cw = p.in[I_CONVW] + l * 3 * CCH; const float* on = p.in[I_OUTN] + l * DM;
    const int lane = c.lane;
    for (int t = c.gw; t < T; t += c.ngw) {
        bf16* row = PROJ + (size_t)t * INC;
        const float gq = qna[lane], gk = kna[lane];
#pragma unroll
        for (int h = 0; h < NAH; ++h) {
            const float vq = bf2f(row[C_QA + h * HD + lane]), vk = bf2f(row[C_KA + h * HD + lane]);
            const float rq = rsqrtf(wave_sum(vq * vq) * (1.f / HD) + EPS), rk = rsqrtf(wave_sum(vk * vk) * (1.f / HD) + EPS);
            row[C_QA + h * HD + lane] = (bf16)f2bf(vq * rq * gq); row[C_KA + h * HD + lane] = (bf16)f2bf(vk * rk * gk);
        }
        {
            const u32x2 w = *(const u32x2*)(row + C_CQ + 4 * lane);
            float a0 = bflo(w.x), a1 = bfhi(w.x), a2 = bflo(w.y), a3 = bfhi(w.y);
            const float r = rsqrtf(wave_sum(a0 * a0 + a1 * a1 + a2 * a2 + a3 * a3) * (1.f / QR) + EPS);
            const f32x4 g = *(const f32x4*)(cqn + 4 * lane);
            u32x2 o; o.x = pk2(a0 * r * g.x, a1 * r * g.y); o.y = pk2(a2 * r * g.z, a3 * r * g.w);
            *(u32x2*)(row + C_CQ + 4 * lane) = o;
        }
        {
            const unsigned w = *(const unsigned*)(row + C_CKV + 2 * lane);
            float a0 = bflo(w), a1 = bfhi(w);
            const float r = rsqrtf(wave_sum(a0 * a0 + a1 * a1) * (1.f / KVR) + EPS);
            const f32x2 g = *(const f32x2*)(ckvn + 2 * lane);
            *(unsigned*)(row + C_CKV + 2 * lane) = pk2(a0 * r * g.x, a1 * r * g.y);
        }
        {
            const int s = t % SEQ; float y[4] = {0.f, 0.f, 0.f, 0.f};
#pragma unroll
            for (int k = 0; k < 3; ++k) {
                const int ss = s + k - 1;
                if (ss >= 0 && ss < SEQ) {
                    const bf16* r2 = PROJ + (size_t)(t + k - 1) * INC;
                    const u32x2 hc = *(const u32x2*)(r2 + C_HC + 4 * lane), cc = *(const u32x2*)(r2 + C_CC + 4 * lane);
                    const f32x4 w = *(const f32x4*)(cw + k * CCH + 4 * lane);
                    y[0] += w.x * (bflo(hc.x) * bflo(cc.x)); y[1] += w.y * (bfhi(hc.x) * bfhi(cc.x));
                    y[2] += w.z * (bflo(hc.y) * bflo(cc.y)); y[3] += w.w * (bfhi(hc.y) * bfhi(cc.y));
                }
            }
            const u32x2 bc = *(const u32x2*)(row + C_BC + 4 * lane);
            const float o0 = bflo(bc.x) * y[0], o1 = bfhi(bc.x) * y[1], o2 = bflo(bc.y) * y[2], o3 = bfhi(bc.y) * y[3];
            const float r = rsqrtf(wave_sum(o0 * o0 + o1 * o1 + o2 * o2 + o3 * o3) * (1.f / CCH) + EPS);
            const f32x4 g = *(const f32x4*)(on + AW + BW + 4 * lane);
            u32x2 o; o.x = pk2(o0 * r * g.x, o1 * r * g.y); o.y = pk2(o2 * r * g.z, o3 * r * g.w);
            *(u32x2*)(MIX + (size_t)t * DM + AW + BW + 4 * lane) = o;
        }
    }
}

__device__ __forceinline__ void phase_c2(const Params& p, const Ctx& c0, int l) {
    const Ctx c = launder(c0);
    const bf16* PROJ = (const bf16*)(p.ws + WS_PROJ);
    bf16* QB = (bf16*)(p.ws + WS_QB); bf16* KV = (bf16*)(p.ws + WS_KV);
    {
        NGemm g{PROJ + C_CQ, INC, nullptr, 0, p.in[I_WUQ] + (size_t)l * QR * (MH * DQK), nullptr, MH * DQK, MH * DQK, QR};
        const int tn_n = (MH * DQK + 127) / 128, ntile = (T / 128) * tn_n;
        for (int tt = c.bid; tt < ntile; tt += c.G) {
            ngemm_tile<false>(g, tt / tn_n, tt % tn_n, c.lds, [=](int r, int col, const float (&v)[4], const float (&)[4]) {
                u32x2 w; w.x = pk2(v[0], v[1]); w.y = pk2(v[2], v[3]); *(u32x2*)(QB + (size_t)r * (MH * DQK) + col) = w; });
        }
    }
    {
        NGemm g{PROJ + C_CKV, INC, nullptr, 0, p.in[I_WUKV] + (size_t)l * KVR * (MH * 128), nullptr, MH * 128, MH * 128, KVR};
        const int tn_n = (MH * 128) / 128, ntile = (T / 128) * tn_n;
        for (int tt = c.bid; tt < ntile; tt += c.G) {
            ngemm_tile<false>(g, tt / tn_n, tt % tn_n, c.lds, [=](int r, int col, const float (&v)[4], const float (&)[4]) {
                u32x2 w; w.x = pk2(v[0], v[1]); w.y = pk2(v[2], v[3]); *(u32x2*)(KV + (size_t)r * (MH * 128) + col) = w; });
        }
    }
}

__device__ __forceinline__ void phase_c3(const Params& p, const Ctx& c0, int l) {
    const Ctx c = launder(c0);
    const bf16* PROJ = (const bf16*)(p.ws + WS_PROJ);
    bf16* QB = (bf16*)(p.ws + WS_QB); bf16* KB = (bf16*)(p.ws + WS_KB); const bf16* KV = (const bf16*)(p.ws + WS_KV);
    const f32x2* tab = (const f32x2*)(p.ws + WS_ROPE);
    const float* qnb = p.in[I_QNB] + l * DQK; const float* knb = p.in[I_KNB] + l * DQK;
    const int lane = c.lane, i16 = lane & 15;
    const float gq1 = qnb[lane], gq2 = lane < 32 ? qnb[64 + lane] : 0.f, gk1 = knb[lane], gk2 = lane < 32 ? knb[64 + lane] : 0.f;
    for (int t = c.gw; t < T; t += c.ngw) {
        const int s = t % SEQ; const f32x2 cs = tab[s * 16 + i16];
        const float krv = lane < 32 ? bf2f(PROJ[(size_t)t * INC + C_KR + lane]) : 0.f;
#pragma unroll
        for (int h = 0; h < MH; ++h) {
            {
                bf16* q = QB + (size_t)t * (MH * DQK) + h * DQK;
                const float v1 = bf2f(q[lane]), v2 = lane < 32 ? bf2f(q[64 + lane]) : 0.f;
                const float r = rsqrtf(wave_sum(v1 * v1 + v2 * v2) * (1.f / DQK) + EPS);
                const float n1 = v1 * r * gq1, n2 = v2 * r * gq2;
                const float pr = __shfl_xor(n2, 16);
                const float ro = lane < 16 ? (n2 * cs.x - pr * cs.y) : (n2 * cs.x + pr * cs.y);
                q[lane] = (bf16)f2bf(n1 * QSCALE);
                if (lane < 32) q[64 + lane] = (bf16)f2bf(ro * QSCALE);
            }
            {
                const float v1 = bf2f(KV[(size_t)t * (MH * 128) + h * 128 + lane]), v2 = krv;
                const float r = rsqrtf(wave_sum(v1 * v1 + v2 * v2) * (1.f / DQK) + EPS);
                const float n1 = v1 * r * gk1, n2 = v2 * r * gk2;
                const float pr = __shfl_xor(n2, 16);
                const float ro = lane < 16 ? (n2 * cs.x - pr * cs.y) : (n2 * cs.x + pr * cs.y);
                bf16* k = KB + (size_t)t * (MH * DQK) + h * DQK;
                k[lane] = (bf16)f2bf(n1);
                if (lane < 32) k[64 + lane] = (bf16)f2bf(ro);
            }
        }
    }
}

__device__ __forceinline__ void phase_na_simple(const Params& p, const Ctx& c0, int l) {
    const Ctx c = launder(c0);
    const bf16* PROJ = (const bf16*)(p.ws + WS_PROJ); bf16* OA = (bf16*)(p.ws + WS_OA);
    const float* rpb = p.in[I_RPB] + (size_t)l * NAH * 15 * 31;
    for (int it = c.bid * 512 + c.tid; it < T * NAH; it += c.G * 512) {
        const int h = it / T, t = it % T;
        const int b = t / SEQ, s = t % SEQ, r = s / GRID_W, cc = s % GRID_W;
        const int r0 = min(max(r - WH / 2, 0), ROWS - WH), c0 = min(max(cc - WW / 2, 0), GRID_W - WW);
        u32x4 qv[8];
        {
            const u32x4* qp = (const u32x4*)(PROJ + (size_t)t * INC + C_QA + h * HD);
#pragma unroll
            for (int i = 0; i < 8; ++i) qv[i] = qp[i];
        }
        float o[64];
#pragma unroll
        for (int d = 0; d < 64; ++d) o[d] = 0.f;
        float m = -1e30f, lsum = 0.f;
#pragma unroll 1
        for (int kk = 0; kk < WH * WW; ++kk) {
            const int i = kk / WW, j = kk % WW;
            const int kt = b * SEQ + (r0 + i) * GRID_W + c0 + j;
            const u32x4* kp = (const u32x4*)(PROJ + (size_t)kt * INC + C_KA + h * HD);
            float sdot = 0.f;
#pragma unroll
            for (int u = 0; u < 8; ++u) { const u32x4 w = kp[u];
                const u32x4 qq = qv[u];
                sdot += bflo(qq.x) * bflo(w.x) + bfhi(qq.x) * bfhi(w.x) + bflo(qq.y) * bflo(w.y) + bfhi(qq.y) * bfhi(w.y) + bflo(qq.z) * bflo(w.z) + bfhi(qq.z) * bfhi(w.z) + bflo(qq.w) * bflo(w.w) + bfhi(qq.w) * bfhi(w.w); }
            const float sc = sdot * 0.125f + rpb[(h * 15 + (r0 + i - r + WH - 1)) * 31 + (c0 + j - cc + WW - 1)];
            if (sc > m) { const float a = __expf(m - sc); lsum *= a;
#pragma unroll
                for (int d = 0; d < 64; ++d) o[d] *= a;
                m = sc; }
            const float pp = __expf(sc - m); lsum += pp;
            const u32x4* vp = (const u32x4*)(PROJ + (size_t)kt * INC + C_VA + h * HD);
#pragma unroll
            for (int u = 0; u < 8; ++u) { const u32x4 w = vp[u];
                o[8 * u] += pp * bflo(w.x); o[8 * u + 1] += pp * bfhi(w.x); o[8 * u + 2] += pp * bflo(w.y); o[8 * u + 3] += pp * bfhi(w.y);
                o[8 * u + 4] += pp * bflo(w.z); o[8 * u + 5] += pp * bfhi(w.z); o[8 * u + 6] += pp * bflo(w.w); o[8 * u + 7] += pp * bfhi(w.w); }
        }
        const float inv = 1.f / lsum;
        u32x4* op = (u32x4*)(OA + (size_t)t * AW + h * HD);
#pragma unroll
        for (int u = 0; u < 8; ++u) { u32x4 w; w.x = pk2(o[8 * u] * inv, o[8 * u + 1] * inv); w.y = pk2(o[8 * u + 2] * inv, o[8 * u + 3] * inv); w.z = pk2(o[8 * u + 4] * inv, o[8 * u + 5] * inv); w.w = pk2(o[8 * u + 6] * inv, o[8 * u + 7] * inv); op[u] = w; }
    }
}

__device__ __forceinline__ void phase_mla_simple(const Params& p, const Ctx& c0) {
    const Ctx c = launder(c0);
    const bf16* QB = (const bf16*)(p.ws + WS_QB); const bf16* KB = (const bf16*)(p.ws + WS_KB); const bf16* KV = (const bf16*)(p.ws + WS_KV);
    bf16* OB = (bf16*)(p.ws + WS_OB);
    float* Ks = (float*)c.lds; float* Vs = Ks + 64 * DQK;
    const int tid = c.tid;
    for (int u = c.bid; u < BATCH * MH * (SEQ / 512); u += c.G) {
        const int b = u / (MH * (SEQ / 512)), h = (u / (SEQ / 512)) % MH, qc = u % (SEQ / 512);
        const int t = b * SEQ + qc * 512 + tid;
        float q[DQK];
        {
            const u32x4* qp = (const u32x4*)(QB + (size_t)t * (MH * DQK) + h * DQK);
#pragma unroll
            for (int i = 0; i < 12; ++i) { const u32x4 w = qp[i]; q[8 * i] = bflo(w.x); q[8 * i + 1] = bfhi(w.x); q[8 * i + 2] = bflo(w.y); q[8 * i + 3] = bfhi(w.y); q[8 * i + 4] = bflo(w.z); q[8 * i + 5] = bfhi(w.z); q[8 * i + 6] = bflo(w.w); q[8 * i + 7] = bfhi(w.w); }
        }
        float o[DV];
#pragma unroll
        for (int d = 0; d < DV; ++d) o[d] = 0.f;
        float m = -1e30f, lsum = 0.f;
#pragma unroll 1
        for (int kt = 0; kt < SEQ / 64; ++kt) {
            __syncthreads();
            for (int i = tid; i < 64 * DQK / 4; i += 512) { const int key = i / (DQK / 4), c4 = i % (DQK / 4);
                const u32x2 w = *(const u32x2*)(KB + (size_t)(b * SEQ + kt * 64 + key) * (MH * DQK) + h * DQK + c4 * 4);
                *(f32x4*)(Ks + key * DQK + c4 * 4) = (f32x4){bflo(w.x), bfhi(w.x), bflo(w.y), bfhi(w.y)}; }
            for (int i = tid; i < 64 * DV / 4; i += 512) { const int key = i / (DV / 4), c4 = i % (DV / 4);
                const u32x2 w = *(const u32x2*)(KV + (size_t)(b * SEQ + kt * 64 + key) * (MH * 128) + h * 128 + NOPE + c4 * 4);
                *(f32x4*)(Vs + key * DV + c4 * 4) = (f32x4){bflo(w.x), bfhi(w.x), bflo(w.y), bfhi(w.y)}; }
            __syncthreads();
#pragma unroll 1
            for (int j = 0; j < 64; ++j) {
                float s0 = 0.f, s1 = 0.f;
#pragma unroll
                for (int d = 0; d < DQK; d += 4) { const f32x4 k4 = *(const f32x4*)(Ks + j * DQK + d); s0 += q[d] * k4.x + q[d + 1] * k4.y; s1 += q[d + 2] * k4.z + q[d + 3] * k4.w; }
                const float sc = s0 + s1;
                if (sc > m) { const float a = exp2f(m - sc); lsum *= a;
#pragma unroll
                    for (int d = 0; d < DV; ++d) o[d] *= a;
                    m = sc; }
                const float pp = exp2f(sc - m); lsum += pp;
#pragma unroll
                for (int d = 0; d < DV; d += 4) { const f32x4 v4 = *(const f32x4*)(Vs + j * DV + d); o[d] += pp * v4.x; o[d + 1] += pp * v4.y; o[d + 2] += pp * v4.z; o[d + 3] += pp * v4.w; }
            }
        }
        const float inv = 1.f / lsum;
        u32x4* op = (u32x4*)(OB + (size_t)t * BW + h * DV);
#pragma unroll
        for (int i = 0; i < 8; ++i) { u32x4 w; w.x = pk2(o[8 * i] * inv, o[8 * i + 1] * inv); w.y = pk2(o[8 * i + 2] * inv, o[8 * i + 3] * inv); w.z = pk2(o[8 * i + 4] * inv, o[8 * i + 5] * inv); w.w = pk2(o[8 * i + 6] * inv, o[8 * i + 7] * inv); op[i] = w; }
    }
    __syncthreads();
}

__device__ __forceinline__ void phase_outnorm(const Params& p, const Ctx& c0, int l) {
    const Ctx c = launder(c0);
    const bf16* OA = (const bf16*)(p.ws + WS_OA); const bf16* OB = (const bf16*)(p.ws + WS_OB); bf16* MIX = (bf16*)(p.ws + WS_HN);
    const float* on = p.in[I_OUTN] + l * DM; const int lane = c.lane;
    for (int t = c.gw; t < T; t += c.ngw) {
#pragma unroll
        for (int grp = 0; grp < 2; ++grp) {
            const bf16* src = (grp ? OB : OA) + (size_t)t * 384;
            float v[6]; float ss = 0.f;
#pragma unroll
            for (int j = 0; j < 6; ++j) { v[j] = bf2f(src[lane + 64 * j]); ss += v[j] * v[j]; }
            const float r = rsqrtf(wave_sum(ss) * (1.f / 384.f) + EPS);
#pragma unroll
            for (int j = 0; j < 6; ++j) MIX[(size_t)t * DM + grp * 384 + lane + 64 * j] = (bf16)f2bf(v[j] * r * on[grp * 384 + lane + 64 * j]);
        }
    }
}

__device__ __forceinline__ void phase_wout(const Params& p, const Ctx& c0, int l) {
    const Ctx c = launder(c0);
    NGemm g{(const bf16*)(p.ws + WS_HN), DM, nullptr, 0, p.in[I_WOUT] + (size_t)l * DM * DM, nullptr, DM, DM, DM};
    const float* xres = l == 0 ? p.in[I_X] : p.out; float* out = p.out;
    const int tn_n = DM / 128, ntile = (T / 128) * tn_n;
    for (int tt = c.bid; tt < ntile; tt += c.G) {
        ngemm_tile<false>(g, tt / tn_n, tt % tn_n, c.lds, [=](int r, int col, const float (&v)[4], const float (&)[4]) {
            const f32x4 xr = *(const f32x4*)(xres + (size_t)r * DM + col);
            *(f32x4*)(out + (size_t)r * DM + col) = (f32x4){xr.x + v[0], xr.y + v[1], xr.z + v[2], xr.w + v[3]}; });
    }
}

__device__ __forceinline__ void phase_router(const Params& p, const Ctx& c0, int l) {
    const Ctx c = launder(c0);
    bf16* XN = (bf16*)(p.ws + WS_HN); float* AFF = (float*)(p.ws + WS_AFF);
    const float* g = p.in[I_NFFN] + l * DM; const float* wr = p.in[I_WR] + (size_t)l * DM * NE; const float* br = p.in[I_BR] + l * NE;
    const int lane = c.lane;
    for (int t = c.gw; t < T; t += c.ngw) {
        f32x4 v[4], xn[4]; row_load(p.out + (size_t)t * DM, lane, v);
        const float rstd = row_rstd(v);
        row_norm_store(v, rstd, g, XN + (size_t)t * DM, lane, xn);
        float lg[NE];
#pragma unroll
        for (int e = 0; e < NE; ++e) lg[e] = 0.f;
#pragma unroll
        for (int j = 0; j < 4; ++j)
#pragma unroll
            for (int cc = 0; cc < 4; ++cc) {
                const float xv = xn[j][cc]; const f32x4* w4 = (const f32x4*)(wr + (size_t)(4 * (lane + 64 * j) + cc) * NE);
#pragma unroll
                for (int q = 0; q < 4; ++q) { const f32x4 w = w4[q]; lg[4 * q] += xv * w.x; lg[4 * q + 1] += xv * w.y; lg[4 * q + 2] += xv * w.z; lg[4 * q + 3] += xv * w.w; }
            }
        float mx = -1e30f;
#pragma unroll
        for (int e = 0; e < NE; ++e) { lg[e] = wave_sum(lg[e]) + br[e]; mx = fmaxf(mx, lg[e]); }
        float sum = 0.f;
#pragma unroll
        for (int e = 0; e < NE; ++e) { lg[e] = __expf(lg[e] - mx); sum += lg[e]; }
        const float inv = 1.f / sum; float mine = 0.f;
#pragma unroll
        for (int e = 0; e < NE; ++e) mine = (lane == e) ? lg[e] * inv : mine;
        if (lane < NE) AFF[(size_t)t * NE + lane] = mine;
    }
}

__device__ __forceinline__ void phase_topk(const Params& p, const Ctx& c0) {
    const Ctx c = launder(c0);
    const float* AFF = (const float*)(p.ws + WS_AFF); int* IDX = (int*)(p.ws + WS_IDX); int* INV = (int*)(p.ws + WS_INV);
    unsigned* hist = (unsigned*)c.lds; unsigned* sh = hist + 256;
    const int tid = c.tid;
    for (int pb = c.bid; pb < BATCH * NE; pb += c.G) {
        const int b = pb / NE, e = pb % NE;
        unsigned key[32];
#pragma unroll
        for (int i = 0; i < 32; ++i) key[i] = __float_as_uint(AFF[(size_t)(b * SEQ + i * 512 + tid) * NE + e]);
        unsigned prefix = 0u, mask = 0u; unsigned kr = CAP;
#pragma unroll 1
        for (int pass = 0; pass < 4; ++pass) {
            const int shift = 24 - 8 * pass;
            __syncthreads();
            if (tid < 256) hist[tid] = 0u;
            __syncthreads();
#pragma unroll
            for (int i = 0; i < 32; ++i) if ((key[i] & mask) == prefix) atomicAdd(&hist[(key[i] >> shift) & 255u], 1u);
            __syncthreads();
            if (tid < 64) {
                const unsigned c0 = hist[4 * tid], c1 = hist[4 * tid + 1], c2 = hist[4 * tid + 2], c3 = hist[4 * tid + 3];
                const unsigned tot = c0 + c1 + c2 + c3; unsigned incl = tot;
#pragma unroll
                for (int o = 1; o < 64; o <<= 1) { const unsigned v = __shfl_down(incl, o); if (tid + o < 64) incl += v; }
                unsigned cum = incl - tot;
                const unsigned cs[4] = {c3, c2, c1, c0};
#pragma unroll
                for (int q = 0; q < 4; ++q) { if (cum < kr && cum + cs[q] >= kr) { sh[0] = prefix | ((unsigned)(4 * tid + 3 - q) << shift); sh[1] = kr - cum; } cum += cs[q]; }
            }
            __syncthreads();
            prefix = sh[0]; kr = sh[1]; mask |= 0xFFu << shift;
        }
        const unsigned thr = prefix; const unsigned n_gt = CAP - kr;
        __syncthreads();
        if (tid == 0) { sh[2] = 0u; sh[3] = 0u; sh[4] = 0u; }
        __syncthreads();
        unsigned myeq = 0u;
#pragma unroll
        for (int i = 0; i < 32; ++i) myeq += (key[i] == thr) ? 1u : 0u;
        if (myeq) atomicAdd(&sh[4], myeq);
        __syncthreads();
        const bool fast = (sh[4] == kr);
#pragma unroll
        for (int i = 0; i < 32; ++i) {
            const int t = i * 512 + tid; const unsigned k = key[i]; int slot = -1;
            if (k > thr) slot = (int)atomicAdd(&sh[2], 1u);
            else if (k == thr && fast) slot = (int)(n_gt + atomicAdd(&sh[3], 1u));
            if (k != thr || fast) { INV[(size_t)(b * SEQ + t) * NE + e] = slot; if (slot >= 0) IDX[pb * CAP + slot] = t; }
        }
        if (!fast && tid == 0) {
            unsigned cnt = 0u;
            for (int t = 0; t < SEQ; ++t) {
                if (__float_as_uint(AFF[(size_t)(b * SEQ + t) * NE + e]) == thr) {
                    int slot = -1; if (cnt < kr) { slot = (int)(n_gt + cnt); ++cnt; }
                    INV[(size_t)(b * SEQ + t) * NE + e] = slot; if (slot >= 0) IDX[pb * CAP + slot] = t;
                }
            }
        }
        __syncthreads();
    }
}

__device__ __forceinline__ void phase_moe1(const Params& p, const Ctx& c0, int l) {
    const Ctx c = launder(c0);
    const int* IDX = (const int*)(p.ws + WS_IDX); bf16* HID = (bf16*)(p.ws + WS_HID);
    constexpr int TPP = (CAP / 64) * (FF / 128);
    for (int ft = c.bid; ft < BATCH * NE * TPP; ft += c.G) {
        const int pb = ft / TPP, lt = ft % TPP, b = pb / NE, e = pb % NE;
        NGemm g{(const bf16*)(p.ws + WS_HN), DM, IDX + pb * CAP, b * SEQ, p.in[I_WG] + ((size_t)l * NE + e) * DM * FF, p.in[I_WU] + ((size_t)l * NE + e) * DM * FF, FF, FF, DM};
        bf16* hp = HID + (size_t)pb * CAP * FF;
        ngemm_tile<true>(g, lt / (FF / 128), lt % (FF / 128), c.lds, [=](int r, int col, const float (&v)[4], const float (&u)[4]) {
            float h[4];
#pragma unroll
            for (int i = 0; i < 4; ++i) h[i] = v[i] / (1.f + __expf(-v[i])) * u[i];
            u32x2 w; w.x = pk2(h[0], h[1]); w.y = pk2(h[2], h[3]); *(u32x2*)(hp + (size_t)r * FF + col) = w; });
    }
}
__device__ __forceinline__ void phase_moe2(const Params& p, const Ctx& c0, int l) {
    const Ctx c = launder(c0);
    bf16* YS = (bf16*)(p.ws + WS_YS);
    constexpr int TPP = (CAP / 128) * (DM / 128);
    for (int ft = c.bid; ft < BATCH * NE * TPP; ft += c.G) {
        const int pb = ft / TPP, lt = ft % TPP, e = pb % NE;
        NGemm g{(const bf16*)(p.ws + WS_HID) + (size_t)pb * CAP * FF, FF, nullptr, 0, p.in[I_WD] + ((size_t)l * NE + e) * FF * DM, nullptr, DM, DM, FF};
        bf16* yp = YS + (size_t)pb * CAP * DM;
        ngemm_tile<false>(g, lt / (DM / 128), lt % (DM / 128), c.lds, [=](int r, int col, const float (&v)[4], const float (&)[4]) {
            u32x2 w; w.x = pk2(v[0], v[1]); w.y = pk2(v[2], v[3]); *(u32x2*)(yp + (size_t)r * DM + col) = w; });
    }
}
__device__ __forceinline__ void phase_combine(const Params& p, const Ctx& c0, int l) {
    const Ctx c = launder(c0);
    const float* AFF = (const float*)(p.ws + WS_AFF); const int* INV = (const int*)(p.ws + WS_INV); const bf16* YS = (const bf16*)(p.ws + WS_YS);
    bf16* HN = (bf16*)(p.ws + WS_HN); const int lane = c.lane;
    for (int t = c.gw; t < T; t += c.ngw) {
        const int b = t / SEQ;
        f32x4 v[4]; row_load(p.out + (size_t)t * DM, lane, v);
        const int myslot = lane < NE ? INV[(size_t)t * NE + lane] : -1; const float myg = lane < NE ? AFF[(size_t)t * NE + lane] : 0.f;
#pragma unroll 1
        for (int e = 0; e < NE; ++e) {
            const int slot = __shfl(myslot, e); const float gt = __shfl(myg, e);
            if (slot >= 0) {
                const bf16* yr = YS + ((size_t)(b * NE + e) * CAP + slot) * DM;
#pragma unroll
                for (int j = 0; j < 4; ++j) { const u32x2 w = *(const u32x2*)(yr + 4 * (lane + 64 * j));
                    v[j].x += gt * bflo(w.x); v[j].y += gt * bfhi(w.x); v[j].z += gt * bflo(w.y); v[j].w += gt * bfhi(w.y); }
            }
        }
#pragma unroll
        for (int j = 0; j < 4; ++j) *(f32x4*)(p.out + (size_t)t * DM + 4 * (lane + 64 * j)) = v[j];
        if (l + 1 < DEPTH) { f32x4 xn[4]; const float rstd = row_rstd(v); row_norm_store(v, rstd, p.in[I_NORM_MIX] + (l + 1) * DM, HN + (size_t)t * DM, lane, xn); }
    }
}

#ifndef MK_FUSED
#define MK_FUSED 0
#endif
#define MKCTX extern __shared__ __attribute__((aligned(16))) unsigned char lds[]; Ctx c; c.tid = threadIdx.x; c.lane = c.tid & 63; \
    c.wave = __builtin_amdgcn_readfirstlane(c.tid >> 6); c.G = gridDim.x; c.bid = blockIdx.x; c.gw = c.bid * 8 + c.wave; c.ngw = c.G * 8; c.lds = lds;
enum { PH_PRO = 0, PH_INPROJ, PH_C1, PH_C2, PH_C3, PH_ATTN, PH_OUTNORM, PH_WOUT, PH_ROUTER, PH_TOPK, PH_MOE1, PH_MOE2, PH_COMBINE, PH_NA, PH_MLA };
#if !MK_FUSED
template <int PH> __global__ void __launch_bounds__(512, 2) k_phase(Params p, int l) {
    MKCTX
    if (PH == PH_PRO) { phase_rope_table(p, c); phase_norm0(p, c); }
    if (PH == PH_INPROJ) phase_inproj(p, c, l);
    if (PH == PH_C1) phase_c1(p, c, l);
    if (PH == PH_C2) phase_c2(p, c, l);
    if (PH == PH_C3) phase_c3(p, c, l);
    if (PH == PH_NA) phase_na_simple(p, c, l);
    if (PH == PH_MLA) phase_mla_simple(p, c);
    if (PH == PH_OUTNORM) phase_outnorm(p, c, l);
    if (PH == PH_WOUT) phase_wout(p, c, l);
    if (PH == PH_ROUTER) phase_router(p, c, l);
    if (PH == PH_TOPK) phase_topk(p, c);
    if (PH == PH_MOE1) phase_moe1(p, c, l);
    if (PH == PH_MOE2) phase_moe2(p, c, l);
    if (PH == PH_COMBINE) phase_combine(p, c, l);
}
#else
__global__ void __launch_bounds__(512, 2) fwd(Params p) {
    MKCTX
    volatile LAS unsigned* st = (volatile LAS unsigned*)((LAS unsigned char*)lds + LDS_CTL_OFF);
    if (c.tid < 4) st[c.tid] = 0u;
    __syncthreads();
    XcdBarrier bar = xcd_barrier_post((unsigned*)(p.ws + WS_CTL), st);
    phase_rope_table(p, c);
    phase_norm0(p, c);
    xcd_barrier(bar);
#pragma unroll 1
    for (int l = 0; l < DEPTH; ++l) {
        phase_inproj(p, c, l);       xcd_barrier(bar);
        phase_c1(p, c, l);           xcd_barrier(bar);
        phase_c2(p, c, l);           xcd_barrier(bar);
        phase_c3(p, c, l);           xcd_barrier(bar);
        phase_na_simple(p, c, l);
        phase_mla_simple(p, c);      xcd_barrier(bar);
        phase_outnorm(p, c, l);      xcd_barrier(bar);
        phase_wout(p, c, l);         xcd_barrier(bar);
        phase_router(p, c, l);       xcd_barrier(bar);
        phase_topk(p, c);            xcd_barrier(bar);
        phase_moe1(p, c, l);         xcd_barrier(bar);
        phase_moe2(p, c, l);         xcd_barrier(bar);
        phase_combine(p, c, l);      xcd_barrier(bar);
    }
}
#endif

extern "C" void kernel_launch(void* const* d_in, const int* in_sizes, int n_in, void* d_out, int out_size, void* d_ws, size_t ws_size, hipStream_t stream) {
    static int grid = 0;
    if (grid == 0) {
        if (n_in != N_IN || in_sizes[0] != T * DM || out_size != T * DM || ws_size < WS_END) {
            fprintf(stderr, "kernel_launch: shape mismatch n_in %d in0 %d out %d ws %zu (need %zu)\n", n_in, n_in > 0 ? in_sizes[0] : -1, out_size, ws_size, (size_t)WS_END); grid = -1; return; }
        int dev = 0, cus = 0;
        if (hipGetDevice(&dev) != hipSuccess || hipDeviceGetAttribute(&cus, hipDeviceAttributeMultiprocessorCount, dev) != hipSuccess) { grid = -1; return; }
#if MK_FUSED
        if (hipFuncSetAttribute((const void*)fwd, hipFuncAttributeMaxDynamicSharedMemorySize, LDS_BYTES) != hipSuccess) { fprintf(stderr, "kernel_launch: hipFuncSetAttribute failed\n"); grid = -1; return; }
#endif
        grid = cus;
    }
    if (grid < 0) return;
    Params p{};
    for (int i = 0; i < N_IN; ++i) p.in[i] = (const float*)d_in[i];
    p.out = (float*)d_out; p.ws = (unsigned char*)d_ws;
#if MK_FUSED
    if (hipMemsetAsync((char*)d_ws + WS_CTL, 0, CTL_ZERO_BYTES, stream) != hipSuccess) return;
    hipLaunchKernelGGL(fwd, dim3(grid), dim3(512), LDS_BYTES, stream, p);
#else
    constexpr int SL = 65536;
#define LAUNCH(PH, l) hipLaunchKernelGGL(k_phase<PH>, dim3(grid), dim3(512), SL, stream, p, l)
    LAUNCH(PH_PRO, 0);
    for (int l = 0; l < DEPTH; ++l) {
        LAUNCH(PH_INPROJ, l); LAUNCH(PH_C1, l); LAUNCH(PH_C2, l); LAUNCH(PH_C3, l); LAUNCH(PH_NA, l); LAUNCH(PH_MLA, l);
        LAUNCH(PH_OUTNORM, l); LAUNCH(PH_WOUT, l); LAUNCH(PH_ROUTER, l); LAUNCH(PH_TOPK, l); LAUNCH(PH_MOE1, l); LAUNCH(PH_MOE2, l); LAUNCH(PH_COMBINE, l);
    }
#endif
    const hipError_t le = hipPeekAtLastError();
    if (le != hipSuccess) fprintf(stderr, "kernel_launch: launch failed: %s\n", hipGetErrorName(le));
}
```

```cpp
#include <hip/hip_runtime.h>
#include <cstdio>
#include <cstdint>

#define LAS __attribute__((address_space(3)))
typedef unsigned short bf16;
typedef float f32x4 __attribute__((ext_vector_type(4)));
typedef float f32x2 __attribute__((ext_vector_type(2)));
typedef unsigned u32x4 __attribute__((ext_vector_type(4)));
typedef unsigned u32x2 __attribute__((ext_vector_type(2)));

constexpr int BATCH = 2, SEQ = 16384, T = BATCH * SEQ, DM = 1024, DEPTH = 2;
constexpr int GRID_W = 64, ROWS = SEQ / GRID_W, HD = 64;
constexpr int NAH = 6, WH = 8, WW = 16, AW = 384;
constexpr int MH = 6, QR = 256, KVR = 128, NOPE = 64, ROPE = 32, DQK = 96, DV = 64, BW = 384;
constexpr int CCH = 256, INC = 2336;
constexpr int NE = 16, FF = 1024, CAP = 2048;
constexpr float EPS = 1e-6f;
constexpr int C_QA = 0, C_KA = 384, C_VA = 768, C_CQ = 1152, C_CKV = 1408, C_KR = 1536, C_HC = 1568, C_BC = 1824, C_CC = 2080;
constexpr float QSCALE = 0.10206207261596575f * 1.4426950408889634f;

enum { I_X = 0, I_NORM_MIX, I_W_IN, I_QNA, I_KNA, I_RPB, I_CQN, I_WUQ, I_CKVN, I_WUKV, I_QNB, I_KNB, I_CONVW, I_OUTN, I_WOUT, I_NFFN, I_WR, I_BR, I_WG, I_WU, I_WD, N_IN };

constexpr size_t MiB = 1u << 20;
constexpr size_t WS_CTL = 0, CTL_ZERO_BYTES = 65536;
constexpr size_t WS_ROPE = 2 * MiB;
constexpr size_t WS_WSMALL = 4 * MiB;
constexpr size_t WS_WEGU = 20 * MiB, WS_WED = 84 * MiB;
constexpr size_t WS_HN = 116 * MiB;
constexpr size_t WS_PROJ = 180 * MiB, WS_HID = 180 * MiB;
constexpr size_t WS_QB = 326 * MiB, WS_KB = 362 * MiB, WS_KV = 398 * MiB, WS_OA = 446 * MiB, WS_OB = 470 * MiB;
constexpr size_t WS_YS = 326 * MiB;
constexpr size_t WS_AFF = 494 * MiB, WS_IDX = 496 * MiB, WS_INV = 497 * MiB, WS_END = 500 * MiB;

constexpr int LDS_BYTES = 147456;
constexpr int LDS_CTL_OFF = 131072;

__device__ __forceinline__ float bf2f(bf16 v) { return __uint_as_float((unsigned)v << 16); }
__device__ __forceinline__ float bflo(unsigned u) { return __uint_as_float(u << 16); }
__device__ __forceinline__ float bfhi(unsigned u) { return __uint_as_float(u & 0xffff0000u); }
__device__ __forceinline__ unsigned f2bf(float f) { unsigned u = __float_as_uint(f); return (u + 0x7fffu + ((u >> 16) & 1u)) >> 16; }
__device__ __forceinline__ unsigned pk2(float lo, float hi) { return f2bf(lo) | (f2bf(hi) << 16); }
__device__ __forceinline__ float wave_sum(float v) {
#pragma unroll
    for (int o = 1; o < 64; o <<= 1) v += __shfl_xor(v, o);
    return v;
}

#define XB_TMO      128
#define XB_XCNT(j)  (256  + 64 * (j))
#define XB_XSUB(j)  (1280 + 64 * (j))
#define XB_XGEN(j)  (2304 + 64 * (j))
#define XB_TOP      3328
#define XB_TOPGEN   3392
#define XCD_BAR_WORDS 3456
#define XB_SPIN_CAP (1u << 22)

__device__ __forceinline__ unsigned xb_ld(unsigned* p)              { return __hip_atomic_load(p, __ATOMIC_RELAXED, __HIP_MEMORY_SCOPE_AGENT); }
__device__ __forceinline__ unsigned xb_add(unsigned* p, unsigned v) { return __hip_atomic_fetch_add(p, v, __ATOMIC_RELAXED, __HIP_MEMORY_SCOPE_AGENT); }
__device__ __forceinline__ unsigned xb_xcc_id() { return (unsigned)__builtin_amdgcn_s_getreg((3 << 11) | 20) & 0xFu; }
#define XB_SPIN(cond, bar) do { unsigned _sp = 0; while (cond) { __builtin_amdgcn_s_sleep(1); \
    if ((++_sp & 255u) == 0u) { if (xb_ld(&(bar)[XB_TMO])) break; if (_sp > XB_SPIN_CAP) { atomicAdd(&(bar)[XB_TMO], 1u); break; } } } } while (0)

struct XcdBarrier { unsigned* bar; unsigned x; volatile LAS unsigned* st; };

__device__ __forceinline__ XcdBarrier xcd_barrier_post(unsigned* bar, volatile LAS unsigned* st) {
    XcdBarrier b; b.bar = bar; b.x = xb_xcc_id(); b.st = st;
    if (threadIdx.x == 0) (void)xb_add(&bar[XB_XCNT(b.x)], 1u);
    return b;
}
__device__ __forceinline__ void xcd_barrier_complete(unsigned* bar, unsigned x, unsigned& nloc, unsigned& nx) {
    const unsigned G = gridDim.x * gridDim.y * gridDim.z;
    unsigned sum, cnt, mine, sp = 0u;
    for (;;) {
        sum = 0u; cnt = 0u; mine = 0u;
#pragma unroll
        for (unsigned j = 0; j < 16; ++j) { const unsigned c = xb_ld(&bar[XB_XCNT(j)]); sum += c; cnt += (c > 0u) ? 1u : 0u; mine = (j == x) ? c : mine; }
        if (sum == G) break;
        __builtin_amdgcn_s_sleep(1);
        if ((++sp & 255u) == 0u) { if (xb_ld(&bar[XB_TMO])) break; if (sp > XB_SPIN_CAP) { atomicAdd(&bar[XB_TMO], 1u); break; } }
    }
    nloc = mine > 0u ? mine : 1u; nx = cnt > 0u ? cnt : 1u;
}
__device__ __forceinline__ void xcd_barrier(const XcdBarrier& b) {
    asm volatile("s_waitcnt vmcnt(0)" ::: "memory");
    __syncthreads();
    if (threadIdx.x == 0) {
        unsigned* bar = b.bar;
        __builtin_amdgcn_s_waitcnt(0);
        unsigned nloc = b.st[0], nx = b.st[1];
        if (nloc == 0u) { xcd_barrier_complete(bar, b.x, nloc, nx); b.st[0] = nloc; b.st[1] = nx; }
        const unsigned old = xb_add(&bar[XB_XSUB(b.x)], 1u);
        const unsigned gen = old / nloc;
        if (old + 1u == (gen + 1u) * nloc) {
            __builtin_amdgcn_fence(__ATOMIC_RELEASE, "agent");
            asm volatile("s_waitcnt vmcnt(0)" ::: "memory");
            const unsigned og = xb_add(&bar[XB_TOP], 1u);
            const unsigned tg = og / nx;
            if (og + 1u == (tg + 1u) * nx) xb_add(&bar[XB_TOPGEN], 1u);
            else XB_SPIN(xb_ld(&bar[XB_TOPGEN]) == tg, bar);
            __builtin_amdgcn_fence(__ATOMIC_ACQUIRE, "agent");
            xb_add(&bar[XB_XGEN(b.x)], 1u);
            asm volatile("s_waitcnt vmcnt(0)" ::: "memory");
        } else {
            XB_SPIN(xb_ld(&bar[XB_XGEN(b.x)]) == gen, bar);
            __builtin_amdgcn_fence(__ATOMIC_ACQUIRE, "agent");
            asm volatile("s_waitcnt vmcnt(0)" ::: "memory");
        }
    }
    __syncthreads();
}

struct Params { const float* in[N_IN]; float* out; unsigned char* ws; };

struct Ctx {
    int tid, lane, wave, G, bid;
    int gw, ngw;
    unsigned char* lds;
};
__device__ __forceinline__ Ctx launder(const Ctx& c0) {
    Ctx c = c0; int tid = c0.tid, bid = c0.bid, G = c0.G;
    asm volatile("" : "+v"(tid)); asm volatile("" : "+s"(bid)); asm volatile("" : "+s"(G));
    c.tid = tid; c.lane = tid & 63; c.wave = __builtin_amdgcn_readfirstlane(tid >> 6); c.bid = bid; c.G = G;
    c.gw = bid * 8 + c.wave; c.ngw = G * 8;
    return c;
}

__constant__ double ROPE_C[16] = {0.5403023058681398, 0.8460091102817079, 0.9504152802551828, 0.9842302344700946, 0.9950041652780258, 0.9984192777926645, 0.9995000416652778, 0.9998418902836144,
                                  0.9999500004166653, 0.9999841886533658, 0.9999950000041666, 0.9999984188615866, 0.9999995000000417, 0.9999998418861211, 0.9999999500000004, 0.9999999841886117};
__constant__ double ROPE_S[16] = {0.8414709848078965, 0.5331684399140229, 0.31098359290718575, 0.17689218624615005, 0.09983341664682815, 0.05620449921469249, 0.03161750640243371, 0.01778185687966613,
                                  0.009999833334166664, 0.005623383613960186, 0.0031622723897082477, 0.0017782784728035289, 0.0009999998333333417, 0.0005623412955523594, 0.0003162277607463752, 0.00017782794006665674};

__device__ __forceinline__ void phase_rope_table(const Params& p, const Ctx& c0) {
    const Ctx c = launder(c0);
    f32x2* tab = (f32x2*)(p.ws + WS_ROPE);
    for (int it = c.bid * 512 + c.tid; it < SEQ * 16; it += c.G * 512) {
        const int s = it >> 4, i = it & 15;
        double bc = ROPE_C[i], bs = ROPE_S[i], rc = 1.0, rs = 0.0;
#pragma unroll
        for (int b = 0; b < 14; ++b) {
            if ((s >> b) & 1) { const double nc = rc * bc - rs * bs, ns = rc * bs + rs * bc; rc = nc; rs = ns; }
            const double c2 = bc * bc - bs * bs, s2 = 2.0 * bc * bs; bc = c2; bs = s2;
        }
        tab[it] = (f32x2){(float)rc, (float)rs};
    }
}

__device__ __forceinline__ void row_load(const float* row, int lane, f32x4 (&v)[4]) {
#pragma unroll
    for (int j = 0; j < 4; ++j) v[j] = *(const f32x4*)(row + 4 * (lane + 64 * j));
}
__device__ __forceinline__ float row_rstd(const f32x4 (&v)[4]) {
    float s = 0.f;
#pragma unroll
    for (int j = 0; j < 4; ++j) s += (v[j].x * v[j].x + v[j].y * v[j].y) + (v[j].z * v[j].z + v[j].w * v[j].w);
    return rsqrtf(wave_sum(s) * (1.f / DM) + EPS);
}
__device__ __forceinline__ void row_norm_store(const f32x4 (&v)[4], float rstd, const float* g, bf16* orow, int lane, f32x4 (&xn)[4]) {
#pragma unroll
    for (int j = 0; j < 4; ++j) {
        const f32x4 gg = *(const f32x4*)(g + 4 * (lane + 64 * j));
        xn[j] = v[j] * rstd * gg;
        u32x2 w; w.x = pk2(xn[j].x, xn[j].y); w.y = pk2(xn[j].z, xn[j].w);
        *(u32x2*)(orow + 4 * (lane + 64 * j)) = w;
    }
}

__device__ __forceinline__ void phase_norm0(const Params& p, const Ctx& c0) {
    const Ctx c = launder(c0);
    const float* x = p.in[I_X]; const float* g = p.in[I_NORM_MIX]; bf16* HN = (bf16*)(p.ws + WS_HN);
    for (int t = c.gw; t < T; t += c.ngw) {
        f32x4 v[4], xn[4]; row_load(x + (size_t)t * DM, c.lane, v);
        const float rstd = row_rstd(v);
        row_norm_store(v, rstd, g, HN + (size_t)t * DM, c.lane, xn);
    }
}

struct NGemm { const bf16* A; int lda; const int* rows; int row_base; const float* W; const float* W2; int ldb; int N; int K; };
template <bool DUAL, class Epi>
__device__ __forceinline__ void ngemm_tile(const NGemm& g, int tm, int tn, unsigned char* lds, const Epi& epi) {
    constexpr int RT = DUAL ? 4 : 8, TM = 16 * RT;
    float* As = (float*)lds;
    float* Bs = As + 16 * 128;
    float* Bs2 = Bs + 16 * 128;
    const int tid = threadIdx.x, ty = tid >> 5, tx = tid & 31;
    float acc[RT][4], acc2[RT][4];
#pragma unroll
    for (int i = 0; i < RT; ++i)
#pragma unroll
        for (int j = 0; j < 4; ++j) { acc[i][j] = 0.f; acc2[i][j] = 0.f; }
    const int ar = DUAL ? (tid >> 3) : (tid >> 2), ak = DUAL ? 2 * (tid & 7) : 4 * (tid & 3);
    const int arow = tm * TM + ar;
    const long asrc = (long)g.row_base + (g.rows ? g.rows[arow] : arow);
    const bf16* ap = g.A + (size_t)asrc * g.lda + ak;
    const int bk = tid >> 5, bn = tn * 128 + (tid & 31) * 4;
    const bool bok = bn < g.N;
    for (int k0 = 0; k0 < g.K; k0 += 16) {
        u32x2 av = (u32x2){0u, 0u};
        if (DUAL) av.x = *(const unsigned*)(ap + k0); else av = *(const u32x2*)(ap + k0);
        f32x4 bv = (f32x4){0.f, 0.f, 0.f, 0.f}, bv2 = (f32x4){0.f, 0.f, 0.f, 0.f};
        if (bok) { bv = *(const f32x4*)(g.W + (size_t)(k0 + bk) * g.ldb + bn); if (DUAL) bv2 = *(const f32x4*)(g.W2 + (size_t)(k0 + bk) * g.ldb + bn); }
        __syncthreads();
        As[(ak + 0) * TM + ar] = bflo(av.x); As[(ak + 1) * TM + ar] = bfhi(av.x);
        if (!DUAL) { As[(ak + 2) * TM + ar] = bflo(av.y); As[(ak + 3) * TM + ar] = bfhi(av.y); }
        *(f32x4*)(Bs + bk * 128 + (tid & 31) * 4) = bv;
        if (DUAL) *(f32x4*)(Bs2 + bk * 128 + (tid & 31) * 4) = bv2;
        __syncthreads();
#pragma unroll
        for (int kk = 0; kk < 16; ++kk) {
            float a[RT];
#pragma unroll
            for (int q = 0; q < RT / 4; ++q) { const f32x4 a4 = *(const f32x4*)(As + kk * TM + ty * RT + 4 * q); a[4 * q] = a4.x; a[4 * q + 1] = a4.y; a[4 * q + 2] = a4.z; a[4 * q + 3] = a4.w; }
            const f32x4 b = *(const f32x4*)(Bs + kk * 128 + tx * 4);
#pragma unroll
            for (int i = 0; i < RT; ++i) { acc[i][0] += a[i] * b.x; acc[i][1] += a[i] * b.y; acc[i][2] += a[i] * b.z; acc[i][3] += a[i] * b.w; }
            if (DUAL) {
                const f32x4 b2 = *(const f32x4*)(Bs2 + kk * 128 + tx * 4);
#pragma unroll
                for (int i = 0; i < RT; ++i) { acc2[i][0] += a[i] * b2.x; acc2[i][1] += a[i] * b2.y; acc2[i][2] += a[i] * b2.z; acc2[i][3] += a[i] * b2.w; }
            }
        }
    }
    const int col0 = tn * 128 + tx * 4;
    if (col0 < g.N) {
#pragma unroll
        for (int i = 0; i < RT; ++i) epi(tm * TM + ty * RT + i, col0, acc[i], acc2[i]);
    }
    __syncthreads();
}

__device__ __forceinline__ void phase_inproj(const Params& p, const Ctx& c0, int l) {
    const Ctx c = launder(c0);
    NGemm g{(const bf16*)(p.ws + WS_HN), DM, nullptr, 0, p.in[I_W_IN] + (size_t)l * DM * INC, nullptr, INC, INC, DM};
    bf16* PROJ = (bf16*)(p.ws + WS_PROJ);
    const int tn_n = (INC + 127) / 128, ntile = (T / 128) * tn_n;
    for (int tt = c.bid; tt < ntile; tt += c.G) {
        const int tm = tt / tn_n, tn = tt % tn_n;
        ngemm_tile<false>(g, tm, tn, c.lds, [=](int r, int col, const float (&v)[4], const float (&)[4]) {
            u32x2 w; w.x = pk2(v[0], v[1]); w.y = pk2(v[2], v[3]); *(u32x2*)(PROJ + (size_t)r * INC + col) = w; });
    }
}

__device__ __forceinline__ void phase_c1(const Params& p, const Ctx& c0, int l) {
    const Ctx c = launder(c0);
    bf16* PROJ = (bf16*)(p.ws + WS_PROJ); bf16* MIX = (bf16*)(p.ws + WS_HN);
    const float* qna = p.in[I_QNA] + l * HD; const float* kna = p.in[I_KNA] + l * HD;
    const float* cqn = p.in[I_CQN] + l * QR; const float* ckvn = p.in[I_CKVN] + l * KVR;
    const float* cw = p.in[I_CONVW] + l * 3 * CCH; const float* on = p.in[I_OUTN] + l * DM;
    const int lane = c.lane;
    for (int t = c.gw; t < T; t += c.ngw) {
        bf16* row = PROJ + (size_t)t * INC;
        const float gq = qna[lane], gk = kna[lane];
#pragma unroll
        for (int h = 0; h < NAH; ++h) {
            const float vq = bf2f(row[C_QA + h * HD + lane]), vk = bf2f(row[C_KA + h * HD + lane]);
            const float rq = rsqrtf(wave_sum(vq * vq) * (1.f / HD) + EPS), rk = rsqrtf(wave_sum(vk * vk) * (1.f / HD) + EPS);
            row[C_QA + h * HD + lane] = (bf16)f2bf(vq * rq * gq); row[C_KA + h * HD + lane] = (bf16)f2bf(vk * rk * gk);
        }
        {
            const u32x2 w = *(const u32x2*)(row + C_CQ + 4 * lane);
            float a0 = bflo(w.x), a1 = bfhi(w.x), a2 = bflo(w.y), a3 = bfhi(w.y);
            const float r = rsqrtf(wave_sum(a0 * a0 + a1 * a1 + a2 * a2 + a3 * a3) * (1.f / QR) + EPS);
            const f32x4 g = *(const f32x4*)(cqn + 4 * lane);
            u32x2 o; o.x = pk2(a0 * r * g.x, a1 * r * g.y); o.y = pk2(a2 * r * g.z, a3 * r * g.w);
            *(u32x2*)(row + C_CQ + 4 * lane) = o;
        }
        {
            const unsigned w = *(const unsigned*)(row + C_CKV + 2 * lane);
            float a0 = bflo(w), a1 = bfhi(w);
            const float r = rsqrtf(wave_sum(a0 * a0 + a1 * a1) * (1.f / KVR) + EPS);
            const f32x2 g = *(const f32x2*)(ckvn + 2 * lane);
            *(unsigned*)(row + C_CKV + 2 * lane) = pk2(a0 * r * g.x, a1 * r * g.y);
        }
        {
            const int s = t % SEQ; float y[4] = {0.f, 0.f, 0.f, 0.f};
#pragma unroll
            for (int k = 0; k < 3; ++k) {
                const int ss = s + k - 1;
                if (ss >= 0 && ss < SEQ) {
                    const bf16* r2 = PROJ + (size_t)(t + k - 1) * INC;
                    const u32x2 hc = *(const u32x2*)(r2 + C_HC + 4 * lane), cc = *(const u32x2*)(r2 + C_CC + 4 * lane);
                    const f32x4 w = *(const f32x4*)(cw + k * CCH + 4 * lane);
                    y[0] += w.x * (bflo(hc.x) * bflo(cc.x)); y[1] += w.y * (bfhi(hc.x) * bfhi(cc.x));
                    y[2] += w.z * (bflo(hc.y) * bflo(cc.y)); y[3] += w.w * (bfhi(hc.y) * bfhi(cc.y));
                }
            }
            const u32x2 bc = *(const u32x2*)(row + C_BC + 4 * lane);
            const float o0 = bflo(bc.x) * y[0], o1 = bfhi(bc.x) * y[1], o2 = bflo(bc.y) * y[2], o3 = bfhi(bc.y) * y[3];
            const float r = rsqrtf(wave_sum(o0 * o0 + o1 * o1 + o2 * o2 + o3 * o3) * (1.f / CCH) + EPS);
            const f32x4 g = *(const f32x4*)(on + AW + BW + 4 * lane);
            u32x2 o; o.x = pk2(o0 * r * g.x, o1 * r * g.y); o.y = pk2(o2 * r * g.z, o3 * r * g.w);
            *(u32x2*)(MIX + (size_t)t * DM + AW + BW + 4 * lane) = o;
        }
    }
}

__device__ __forceinline__ void phase_c2(const Params& p, const Ctx& c0, int l) {
    const Ctx c = launder(c0);
    const bf16* PROJ = (const bf16*)(p.ws + WS_PROJ);
    bf16* QB = (bf16*)(p.ws + WS_QB); bf16* KV = (bf16*)(p.ws + WS_KV);
    {
        NGemm g{PROJ + C_CQ, INC, nullptr, 0, p.in[I_WUQ] + (size_t)l * QR * (MH * DQK), nullptr, MH * DQK, MH * DQK, QR};
        const int tn_n = (MH * DQK + 127) / 128, ntile = (T / 128) * tn_n;
        for (int tt = c.bid; tt < ntile; tt += c.G) {
            ngemm_tile<false>(g, tt / tn_n, tt % tn_n, c.lds, [=](int r, int col, const float (&v)[4], const float (&)[4]) {
                u32x2 w; w.x = pk2(v[0], v[1]); w.y = pk2(v[2], v[3]); *(u32x2*)(QB + (size_t)r * (MH * DQK) + col) = w; });
        }
    }
    {
        NGemm g{PROJ + C_CKV, INC, nullptr, 0, p.in[I_WUKV] + (size_t)l * KVR * (MH * 128), nullptr, MH * 128, MH * 128, KVR};
        const int tn_n = (MH * 128) / 128, ntile = (T / 128) * tn_n;
        for (int tt = c.bid; tt < ntile; tt += c.G) {
            ngemm_tile<false>(g, tt / tn_n, tt % tn_n, c.lds, [=](int r, int col, const float (&v)[4], const float (&)[4]) {
                u32x2 w; w.x = pk2(v[0], v[1]); w.y = pk2(v[2], v[3]); *(u32x2*)(KV + (size_t)r * (MH * 128) + col) = w; });
        }
    }
}

__device__ __forceinline__ void phase_c3(const Params& p, const Ctx& c0, int l) {
    const Ctx c = launder(c0);
    const bf16* PROJ = (const bf16*)(p.ws + WS_PROJ);
    bf16* QB = (bf16*)(p.ws + WS_QB); bf16* KB = (bf16*)(p.ws + WS_KB); const bf16* KV = (const bf16*)(p.ws + WS_KV);
    const f32x2* tab = (const f32x2*)(p.ws + WS_ROPE);
    const float* qnb = p.in[I_QNB] + l * DQK; const float* knb = p.in[I_KNB] + l * DQK;
    const int lane = c.lane, i16 = lane & 15;
    const float gq1 = qnb[lane], gq2 = lane < 32 ? qnb[64 + lane] : 0.f, gk1 = knb[lane], gk2 = lane < 32 ? knb[64 + lane] : 0.f;
    for (int t = c.gw; t < T; t += c.ngw) {
        const int s = t % SEQ; const f32x2 cs = tab[s * 16 + i16];
        const float krv = lane < 32 ? bf2f(PROJ[(size_t)t * INC + C_KR + lane]) : 0.f;
#pragma unroll
        for (int h = 0; h < MH; ++h) {
            {
                bf16* q = QB + (size_t)t * (MH * DQK) + h * DQK;
                const float v1 = bf2f(q[lane]), v2 = lane < 32 ? bf2f(q[64 + lane]) : 0.f;
                const float r = rsqrtf(wave_sum(v1 * v1 + v2 * v2) * (1.f / DQK) + EPS);
                const float n1 = v1 * r * gq1, n2 = v2 * r * gq2;
                const float pr = __shfl_xor(n2, 16);
                const float ro = lane < 16 ? (n2 * cs.x - pr * cs.y) : (n2 * cs.x + pr * cs.y);
                q[lane] = (bf16)f2bf(n1 * QSCALE);
                if (lane < 32) q[64 + lane] = (bf16)f2bf(ro * QSCALE);
            }
            {
                const float v1 = bf2f(KV[(size_t)t * (MH * 128) + h * 128 + lane]), v2 = krv;
                const float r = rsqrtf(wave_sum(v1 * v1 + v2 * v2) * (1.f / DQK) + EPS);
                const float n1 = v1 * r * gk1, n2 = v2 * r * gk2;
                const float pr = __shfl_xor(n2, 16);
                const float ro = lane < 16 ? (n2 * cs.x - pr * cs.y) : (n2 * cs.x + pr * cs.y);
                bf16* k = KB + (size_t)t * (MH * DQK) + h * DQK;
                k[lane] = (bf16)f2bf(n1);
                if (lane < 32) k[64 + lane] = (bf16)f2bf(ro);
            }
        }
    }
}

__device__ __forceinline__ void phase_na_simple(const Params& p, const Ctx& c0, int l) {
    const Ctx c = launder(c0);
    const bf16* PROJ = (const bf16*)(p.ws + WS_PROJ); bf16* OA = (bf16*)(p.ws + WS_OA);
    const float* rpb = p.in[I_RPB] + (size_t)l * NAH * 15 * 31;
    for (int it = c.bid * 512 + c.tid; it < T * NAH; it += c.G * 512) {
        const int h = it / T, t = it % T;
        const int b = t / SEQ, s = t % SEQ, r = s / GRID_W, cc = s % GRID_W;
        const int r0 = min(max(r - WH / 2, 0), ROWS - WH), c0 = min(max(cc - WW / 2, 0), GRID_W - WW);
        u32x4 qv[8];
        {
            const u32x4* qp = (const u32x4*)(PROJ + (size_t)t * INC + C_QA + h * HD);
#pragma unroll
            for (int i = 0; i < 8; ++i) qv[i] = qp[i];
        }
        float o[64];
#pragma unroll
        for (int d = 0; d < 64; ++d) o[d] = 0.f;
        float m = -1e30f, lsum = 0.f;
#pragma unroll 1
        for (int kk = 0; kk < WH * WW; ++kk) {
            const int i = kk / WW, j = kk % WW;
            const int kt = b * SEQ + (r0 + i) * GRID_W + c0 + j;
            const u32x4* kp = (const u32x4*)(PROJ + (size_t)kt * INC + C_KA + h * HD);
            float sdot = 0.f;
#pragma unroll
            for (int u = 0; u < 8; ++u) { const u32x4 w = kp[u];
                const u32x4 qq = qv[u];
                sdot += bflo(qq.x) * bflo(w.x) + bfhi(qq.x) * bfhi(w.x) + bflo(qq.y) * bflo(w.y) + bfhi(qq.y) * bfhi(w.y) + bflo(qq.z) * bflo(w.z) + bfhi(qq.z) * bfhi(w.z) + bflo(qq.w) * bflo(w.w) + bfhi(qq.w) * bfhi(w.w); }
            const float sc = sdot * 0.125f + rpb[(h * 15 + (r0 + i - r + WH - 1)) * 31 + (c0 + j - cc + WW - 1)];
            if (sc > m) { const float a = __expf(m - sc); lsum *= a;
#pragma unroll
                for (int d = 0; d < 64; ++d) o[d] *= a;
                m = sc; }
            const float pp = __expf(sc - m); lsum += pp;
            const u32x4* vp = (const u32x4*)(PROJ + (size_t)kt * INC + C_VA + h * HD);
#pragma unroll
            for (int u = 0; u < 8; ++u) { const u32x4 w = vp[u];
                o[8 * u] += pp * bflo(w.x); o[8 * u + 1] += pp * bfhi(w.x); o[8 * u + 2] += pp * bflo(w.y); o[8 * u + 3] += pp * bfhi(w.y);
                o[8 * u + 4] += pp * bflo(w.z); o[8 * u + 5] += pp * bfhi(w.z); o[8 * u + 6] += pp * bflo(w.w); o[8 * u + 7] += pp * bfhi(w.w); }
        }
        const float inv = 1.f / lsum;
        u32x4* op = (u32x4*)(OA + (size_t)t * AW + h * HD);
#pragma unroll
        for (int u = 0; u < 8; ++u) { u32x4 w; w.x = pk2(o[8 * u] * inv, o[8 * u + 1] * inv); w.y = pk2(o[8 * u + 2] * inv, o[8 * u + 3] * inv); w.z = pk2(o[8 * u + 4] * inv, o[8 * u + 5] * inv); w.w = pk2(o[8 * u + 6] * inv, o[8 * u + 7] * inv); op[u] = w; }
    }
}

__device__ __forceinline__ void phase_mla_simple(const Params& p, const Ctx& c0) {
    const Ctx c = launder(c0);
    const bf16* QB = (const bf16*)(p.ws + WS_QB); const bf16* KB = (const bf16*)(p.ws + WS_KB); const bf16* KV = (const bf16*)(p.ws + WS_KV);
    bf16* OB = (bf16*)(p.ws + WS_OB);
    float* Ks = (float*)c.lds; float* Vs = Ks + 64 * DQK;
    const int tid = c.tid;
    for (int u = c.bid; u < BATCH * MH * (SEQ / 512); u += c.G) {
        const int b = u / (MH * (SEQ / 512)), h = (u / (SEQ / 512)) % MH, qc = u % (SEQ / 512);
        const int t = b * SEQ + qc * 512 + tid;
        float q[DQK];
        {
            const u32x4* qp = (const u32x4*)(QB + (size_t)t * (MH * DQK) + h * DQK);
#pragma unroll
            for (int i = 0; i < 12; ++i) { const u32x4 w = qp[i]; q[8 * i] = bflo(w.x); q[8 * i + 1] = bfhi(w.x); q[8 * i + 2] = bflo(w.y); q[8 * i + 3] = bfhi(w.y); q[8 * i + 4] = bflo(w.z); q[8 * i + 5] = bfhi(w.z); q[8 * i + 6] = bflo(w.w); q[8 * i + 7] = bfhi(w.w); }
        }
        float o[DV];
#pragma unroll
        for (int d = 0; d < DV; ++d) o[d] = 0.f;
        float m = -1e30f, lsum = 0.f;
#pragma unroll 1
        for (int kt = 0; kt < SEQ / 64; ++kt) {
            __syncthreads();
            for (int i = tid; i < 64 * DQK / 4; i += 512) { const int key = i / (DQK / 4), c4 = i % (DQK / 4);
                const u32x2 w = *(const u32x2*)(KB + (size_t)(b * SEQ + kt * 64 + key) * (MH * DQK) + h * DQK + c4 * 4);
                *(f32x4*)(Ks + key * DQK + c4 * 4) = (f32x4){bflo(w.x), bfhi(w.x), bflo(w.y), bfhi(w.y)}; }
            for (int i = tid; i < 64 * DV / 4; i += 512) { const int key = i / (DV / 4), c4 = i % (DV / 4);
                const u32x2 w = *(const u32x2*)(KV + (size_t)(b * SEQ + kt * 64 + key) * (MH * 128) + h * 128 + NOPE + c4 * 4);
                *(f32x4*)(Vs + key * DV + c4 * 4) = (f32x4){bflo(w.x), bfhi(w.x), bflo(w.y), bfhi(w.y)}; }
            __syncthreads();
#pragma unroll 1
            for (int j = 0; j < 64; ++j) {
                float s0 = 0.f, s1 = 0.f;
#pragma unroll
                for (int d = 0; d < DQK; d += 4) { const f32x4 k4 = *(const f32x4*)(Ks + j * DQK + d); s0 += q[d] * k4.x + q[d + 1] * k4.y; s1 += q[d + 2] * k4.z + q[d + 3] * k4.w; }
                const float sc = s0 + s1;
                if (sc > m) { const float a = exp2f(m - sc); lsum *= a;
#pragma unroll
                    for (int d = 0; d < DV; ++d) o[d] *= a;
                    m = sc; }
                const float pp = exp2f(sc - m); lsum += pp;
#pragma unroll
                for (int d = 0; d < DV; d += 4) { const f32x4 v4 = *(const f32x4*)(Vs + j * DV + d); o[d] += pp * v4.x; o[d + 1] += pp * v4.y; o[d + 2] += pp * v4.z; o[d + 3] += pp * v4.w; }
            }
        }
        const float inv = 1.f / lsum;
        u32x4* op = (u32x4*)(OB + (size_t)t * BW + h * DV);
#pragma unroll
        for (int i = 0; i < 8; ++i) { u32x4 w; w.x = pk2(o[8 * i] * inv, o[8 * i + 1] * inv); w.y = pk2(o[8 * i + 2] * inv, o[8 * i + 3] * inv); w.z = pk2(o[8 * i + 4] * inv, o[8 * i + 5] * inv); w.w = pk2(o[8 * i + 6] * inv, o[8 * i + 7] * inv); op[i] = w; }
    }
    __syncthreads();
}

namespace mla {
typedef short bf16x8 __attribute__((ext_vector_type(8)));
typedef short s16x4 __attribute__((ext_vector_type(4)));
typedef float f32x16 __attribute__((ext_vector_type(16)));
constexpr int NW = 8, QBLK = 32, KVBLK = 64;
constexpr int SHM_K = 64 * 256, SHM_V = 64 * 64 * 2;
constexpr int SHM_TOTAL = 2 * SHM_V + 2 * SHM_K + NW * 64 * 4;
constexpr float THR = 8.f;
constexpr int QP = MH * DQK, KP = MH * DQK, VP = MH * 128, OP = BW;
#define KSWZ(row, colB) ((row) * 256 + ((colB) ^ (((row) & 7) << 4)))
#define SBAR() __builtin_amdgcn_sched_barrier(0)
__device__ __forceinline__ int crow(int r, int hi) { return (r & 3) + 8 * (r >> 2) + 4 * hi; }
__device__ __forceinline__ unsigned cvtpk(float lo, float hi) { unsigned r; asm volatile("v_cvt_pk_bf16_f32 %0, %1, %2" : "=v"(r) : "v"(lo), "v"(hi)); return r; }
__device__ __forceinline__ void partialSM(f32x16& p0, f32x16& p1, float& m_reg, float& mn, float& alpha) {
    float pmax = p0[0];
#pragma unroll
    for (int r = 1; r < 16; ++r) pmax = fmaxf(pmax, p0[r]);
#pragma unroll
    for (int r = 0; r < 16; ++r) pmax = fmaxf(pmax, p1[r]);
    { auto rr = __builtin_amdgcn_permlane32_swap(__float_as_uint(pmax), __float_as_uint(pmax), false, false);
      pmax = fmaxf(__uint_as_float(rr[0]), __uint_as_float(rr[1])); }
    if (__builtin_expect(__all(pmax - m_reg <= THR), 1)) { mn = m_reg; alpha = 1.f; }
    else { mn = fmaxf(m_reg, pmax); alpha = __builtin_amdgcn_exp2f(m_reg - mn); m_reg = mn; }
#pragma unroll
    for (int r = 0; r < 16; ++r) { p0[r] -= mn; p1[r] -= mn; }
#pragma unroll
    for (int r = 0; r < 16; ++r) p0[r] = __builtin_amdgcn_exp2f(p0[r]);
}
__device__ __forceinline__ void finishSM(f32x16& p0, f32x16& p1, float alpha, float& l_reg, bf16x8& pa0, bf16x8& pa1, bf16x8& pa2, bf16x8& pa3) {
#pragma unroll
    for (int r = 0; r < 16; ++r) p1[r] = __builtin_amdgcn_exp2f(p1[r]);
    float ps = 0.f;
#pragma unroll
    for (int r = 0; r < 16; ++r) ps += p0[r];
#pragma unroll
    for (int r = 0; r < 16; ++r) ps += p1[r];
    { auto rr = __builtin_amdgcn_permlane32_swap(__float_as_uint(ps), __float_as_uint(ps), false, false);
      ps = __uint_as_float(rr[0]) + __uint_as_float(rr[1]); }
    l_reg = l_reg * alpha + ps;
#define PK4(P, BASE, OUT) do { unsigned a0 = cvtpk(P[BASE + 0], P[BASE + 1]), a1 = cvtpk(P[BASE + 2], P[BASE + 3]);   \
    unsigned b0 = cvtpk(P[BASE + 4], P[BASE + 5]), b1 = cvtpk(P[BASE + 6], P[BASE + 7]);                              \
    auto r0 = __builtin_amdgcn_permlane32_swap(a0, b0, false, false); auto r1 = __builtin_amdgcn_permlane32_swap(a1, b1, false, false); \
    u32x4 w = {r0[0], r1[0], r0[1], r1[1]}; OUT = *reinterpret_cast<bf16x8*>(&w); } while (0)
    PK4(p0, 0, pa0); PK4(p0, 8, pa1); PK4(p1, 0, pa2); PK4(p1, 8, pa3);
#undef PK4
}
__device__ __forceinline__ void qkt(f32x16& p0, f32x16& p1, const char* Ks, const bf16x8* qr, int r32, int hi) {
    p0 = f32x16{}; p1 = f32x16{};
#pragma unroll
    for (int d0 = 0; d0 < DQK / 16; ++d0) { const int cb = (d0 * 16 + hi * 8) * 2;
        const bf16x8 b0 = *reinterpret_cast<const bf16x8*>(Ks + KSWZ(r32, cb));
        const bf16x8 b1 = *reinterpret_cast<const bf16x8*>(Ks + KSWZ(32 + r32, cb));
        p0 = __builtin_amdgcn_mfma_f32_32x32x16_bf16(b0, qr[d0], p0, 0, 0, 0);
        p1 = __builtin_amdgcn_mfma_f32_32x32x16_bf16(b1, qr[d0], p1, 0, 0, 0); }
}
__device__ __forceinline__ int v_st(int k, int c) { const int kk = (k & ~0xC) | ((k & 4) << 1) | ((k & 8) >> 1); return ((kk >> 3) * 2 + (c >> 5)) * 512 + ((kk & 7) * 32 + (c & 31)) * 2; }
__device__ __forceinline__ int v_rd_base(int lane) { return ((lane & 3) << 3) | (((lane >> 2) & 3) << 6) | (((lane >> 4) & 1) << 5) | (((lane >> 5) & 1) << 8); }
constexpr int v_rd_off(int d0, int ks, int half) { return d0 * 512 + ks * 2048 + half * 1024; }
template <int OFF> __device__ __forceinline__ s16x4 tr_read(int vb) {
    s16x4 r; asm volatile("ds_read_b64_tr_b16 %0, %1 offset:%2" : "=&v"(r) : "v"(vb), "i"(OFF) : "memory"); return r;
}
template <int D0> __device__ __forceinline__ void pv_one(f32x16& od, int vb, bf16x8 pa0, bf16x8 pa1, bf16x8 pa2, bf16x8 pa3) {
    const s16x4 l0 = tr_read<v_rd_off(D0, 0, 0)>(vb), h0 = tr_read<v_rd_off(D0, 0, 1)>(vb), l1 = tr_read<v_rd_off(D0, 1, 0)>(vb), h1 = tr_read<v_rd_off(D0, 1, 1)>(vb);
    const s16x4 l2 = tr_read<v_rd_off(D0, 2, 0)>(vb), h2 = tr_read<v_rd_off(D0, 2, 1)>(vb), l3 = tr_read<v_rd_off(D0, 3, 0)>(vb), h3 = tr_read<v_rd_off(D0, 3, 1)>(vb);
    asm volatile("s_waitcnt lgkmcnt(0)" ::: "memory"); SBAR();
#define PK(L, H) (bf16x8){L[0], L[1], L[2], L[3], H[0], H[1], H[2], H[3]}
    od = __builtin_amdgcn_mfma_f32_32x32x16_bf16(pa0, PK(l0, h0), od, 0, 0, 0);
    od = __builtin_amdgcn_mfma_f32_32x32x16_bf16(pa1, PK(l1, h1), od, 0, 0, 0);
    od = __builtin_amdgcn_mfma_f32_32x32x16_bf16(pa2, PK(l2, h2), od, 0, 0, 0);
    od = __builtin_amdgcn_mfma_f32_32x32x16_bf16(pa3, PK(l3, h3), od, 0, 0, 0);
#undef PK
}
__device__ __forceinline__ void pv_all(f32x16* o, int vb, bf16x8 pa0, bf16x8 pa1, bf16x8 pa2, bf16x8 pa3) {
    pv_one<0>(o[0], vb, pa0, pa1, pa2, pa3); pv_one<1>(o[1], vb, pa0, pa1, pa2, pa3);
}
__device__ __forceinline__ void unit(const bf16* __restrict__ Qb, const bf16* __restrict__ Kh, const bf16* __restrict__ Vh, bf16* __restrict__ Ob, int seq, char* lds) {
    const int tid = threadIdx.x, wid = tid >> 6, lane = tid & 63, r32 = lane & 31, hi = lane >> 5;
    char* V_lds = lds; char* K_lds = lds + 2 * SHM_V;
    float* ws = (float*)(lds + 2 * SHM_V + 2 * SHM_K) + wid * 64; float* li_l = ws; float* al_l = ws + 32;
    float m_reg = -1e30f, l_reg = 0.f; f32x16 o[2] = {}; bf16x8 qr[DQK / 16];
    const bf16* Qw = Qb + (long)(wid * QBLK + r32) * QP + hi * 8;
#pragma unroll
    for (int d0 = 0; d0 < DQK / 16; ++d0) qr[d0] = *reinterpret_cast<const bf16x8*>(Qw + d0 * 16);
    const int kA_key = tid / 12, kA_ch = tid % 12, kB_key = (512 + tid) / 12, kB_ch = (512 + tid) % 12, v_key = tid >> 3, v_ch = tid & 7;
    const bool hasB = wid < 4;
    const int kA_dst = KSWZ(kA_key, kA_ch * 16), kB_dst = KSWZ(kB_key, kB_ch * 16), v_dst = v_st(v_key, v_ch * 8);
    const bf16* kA_src = Kh + (long)kA_key * KP + kA_ch * 8; const bf16* kB_src = Kh + (long)kB_key * KP + kB_ch * 8; const bf16* v_src = Vh + (long)v_key * VP + v_ch * 8;
    const int vb0 = (int)(uintptr_t)V_lds + v_rd_base(lane);
    struct { bf16x8 v, ka, kb; } sr_[2];
#define SLOAD(i, k0) do { sr_[i].v = *reinterpret_cast<const bf16x8*>(v_src + (long)(k0) * VP); sr_[i].ka = *reinterpret_cast<const bf16x8*>(kA_src + (long)(k0) * KP); \
    if (hasB) sr_[i].kb = *reinterpret_cast<const bf16x8*>(kB_src + (long)(k0) * KP); } while (0)
#define SWRITE(b, i) do { *(bf16x8*)(V_lds + (b) * SHM_V + v_dst) = sr_[i].v; *(bf16x8*)(K_lds + (b) * SHM_K + kA_dst) = sr_[i].ka; \
    if (hasB) *(bf16x8*)(K_lds + (b) * SHM_K + kB_dst) = sr_[i].kb; } while (0)
#define SWAIT() do { if (hasB) asm volatile("s_waitcnt vmcnt(3)" ::: "memory"); else asm volatile("s_waitcnt vmcnt(2)" ::: "memory"); } while (0)
#define RESC(a) do { if (__any((a) < 1.f)) { if (hi == 0) al_l[r32] = (a); asm volatile("s_waitcnt lgkmcnt(0)" ::: "memory"); \
    _Pragma("unroll") for (int d = 0; d < 2; ++d) _Pragma("unroll") for (int r = 0; r < 16; ++r) o[d][r] *= al_l[crow(r, hi)]; } } while (0)
    f32x16 pA0, pA1, pB0, pB1; float mnA, mnB, alA, alB; bf16x8 pa0, pa1, pa2, pa3; const int NT = seq / KVBLK;
    constexpr int SE = 0, SO = 1;
    SLOAD(SE, 0); asm volatile("s_waitcnt vmcnt(0)" ::: "memory"); SWRITE(0, SE); __syncthreads();
    qkt(pA0, pA1, K_lds, qr, r32, hi); partialSM(pA0, pA1, m_reg, mnA, alA);
    SLOAD(SO, KVBLK); if (2 < NT) SLOAD(SE, 2 * KVBLK);
    SWAIT(); SWRITE(1, SO); __syncthreads();
#pragma unroll 1
    for (int j = 1; j + 1 < NT; j += 2) {
        SBAR(); qkt(pB0, pB1, K_lds + SHM_K, qr, r32, hi);
        finishSM(pA0, pA1, alA, l_reg, pa0, pa1, pa2, pa3); SBAR();
        SLOAD(SO, (j + 2) * KVBLK); SBAR();
        pv_all(o, vb0, pa0, pa1, pa2, pa3); partialSM(pB0, pB1, m_reg, mnB, alB);
        __syncthreads(); SWAIT(); SWRITE(0, SE);
        RESC(alB); __syncthreads();
        SBAR(); qkt(pA0, pA1, K_lds, qr, r32, hi);
        finishSM(pB0, pB1, alB, l_reg, pa0, pa1, pa2, pa3); SBAR();
        if (j + 3 < NT) SLOAD(SE, (j + 3) * KVBLK); SBAR();
        pv_all(o, vb0 + SHM_V, pa0, pa1, pa2, pa3); partialSM(pA0, pA1, m_reg, mnA, alA);
        __syncthreads(); SWAIT(); SWRITE(1, SO);
        RESC(alA); __syncthreads();
    }
    SBAR(); qkt(pB0, pB1, K_lds + SHM_K, qr, r32, hi);
    finishSM(pA0, pA1, alA, l_reg, pa0, pa1, pa2, pa3); SBAR();
    pv_all(o, vb0, pa0, pa1, pa2, pa3); partialSM(pB0, pB1, m_reg, mnB, alB);
    __syncthreads(); RESC(alB);
    finishSM(pB0, pB1, alB, l_reg, pa0, pa1, pa2, pa3); SBAR();
    pv_all(o, vb0 + SHM_V, pa0, pa1, pa2, pa3);
    if (hi == 0) li_l[r32] = l_reg; asm volatile("s_waitcnt lgkmcnt(0)" ::: "memory");
    float rli[16];
#pragma unroll
    for (int r = 0; r < 16; ++r) rli[r] = __builtin_amdgcn_rcpf(li_l[crow(r, hi)]);
    bf16* Ow = Ob + (long)(wid * QBLK) * OP;
#pragma unroll
    for (int r = 0; r < 16; ++r) { const int orow = crow(r, hi);
#pragma unroll
        for (int d0 = 0; d0 < 2; ++d0) Ow[(long)orow * OP + d0 * 32 + r32] = (bf16)f2bf(o[d0][r] * rli[r]); }
    __syncthreads();
#undef SLOAD
#undef SWRITE
#undef SWAIT
#undef RESC
}
#undef KSWZ
#undef SBAR
}

__device__ __forceinline__ void phase_mla(const Params& p, const Ctx& c0) {
    const Ctx c = launder(c0);
    const bf16* QB = (const bf16*)(p.ws + WS_QB); const bf16* KB = (const bf16*)(p.ws + WS_KB); const bf16* KV = (const bf16*)(p.ws + WS_KV);
    bf16* OB = (bf16*)(p.ws + WS_OB);
    constexpr int NQB = SEQ / 256, NU = BATCH * MH * NQB;
    for (int i = 0; ; ++i) {
        int u;
        if (c.G == 256) { const int x = c.bid & 7, j = c.bid >> 3; if (i >= 3) break; const int pair = i * 4 + (x >> 1); u = pair * NQB + (x & 1) * 32 + j; }
        else { u = i * c.G + c.bid; if (u >= NU) break; }
        const int pair = u / NQB, qb = u % NQB, b = pair / MH, h = pair % MH;
        const long row0 = (long)b * SEQ;
        mla::unit(QB + (row0 + qb * 256) * mla::QP + h * DQK, KB + row0 * mla::KP + h * DQK, KV + row0 * mla::VP + h * 128 + NOPE, OB + (row0 + qb * 256) * mla::OP + h * DV, SEQ, (char*)c.lds);
    }
}

__device__ __forceinline__ void phase_outnorm(const Params& p, const Ctx& c0, int l) {
    const Ctx c = launder(c0);
    const bf16* OA = (const bf16*)(p.ws + WS_OA); const bf16* OB = (const bf16*)(p.ws + WS_OB); bf16* MIX = (bf16*)(p.ws + WS_HN);
    const float* on = p.in[I_OUTN] + l * DM; const int lane = c.lane;
    for (int t = c.gw; t < T; t += c.ngw) {
#pragma unroll
        for (int grp = 0; grp < 2; ++grp) {
            const bf16* src = (grp ? OB : OA) + (size_t)t * 384;
            float v[6]; float ss = 0.f;
#pragma unroll
            for (int j = 0; j < 6; ++j) { v[j] = bf2f(src[lane + 64 * j]); ss += v[j] * v[j]; }
            const float r = rsqrtf(wave_sum(ss) * (1.f / 384.f) + EPS);
#pragma unroll
            for (int j = 0; j < 6; ++j) MIX[(size_t)t * DM + grp * 384 + lane + 64 * j] = (bf16)f2bf(v[j] * r * on[grp * 384 + lane + 64 * j]);
        }
    }
}

__device__ __forceinline__ void phase_wout(const Params& p, const Ctx& c0, int l) {
    const Ctx c = launder(c0);
    NGemm g{(const bf16*)(p.ws + WS_HN), DM, nullptr, 0, p.in[I_WOUT] + (size_t)l * DM * DM, nullptr, DM, DM, DM};
    const float* xres = l == 0 ? p.in[I_X] : p.out; float* out = p.out;
    const int tn_n = DM / 128, ntile = (T / 128) * tn_n;
    for (int tt = c.bid; tt < ntile; tt += c.G) {
        ngemm_tile<false>(g, tt / tn_n, tt % tn_n, c.lds, [=](int r, int col, const float (&v)[4], const float (&)[4]) {
            const f32x4 xr = *(const f32x4*)(xres + (size_t)r * DM + col);
            *(f32x4*)(out + (size_t)r * DM + col) = (f32x4){xr.x + v[0], xr.y + v[1], xr.z + v[2], xr.w + v[3]}; });
    }
}

__device__ __forceinline__ void phase_router(const Params& p, const Ctx& c0, int l) {
    const Ctx c = launder(c0);
    bf16* XN = (bf16*)(p.ws + WS_HN); float* AFF = (float*)(p.ws + WS_AFF);
    const float* g = p.in[I_NFFN] + l * DM; const float* wr = p.in[I_WR] + (size_t)l * DM * NE; const float* br = p.in[I_BR] + l * NE;
    const int lane = c.lane;
    for (int t = c.gw; t < T; t += c.ngw) {
        f32x4 v[4], xn[4]; row_load(p.out + (size_t)t * DM, lane, v);
        const float rstd = row_rstd(v);
        row_norm_store(v, rstd, g, XN + (size_t)t * DM, lane, xn);
        float lg[NE];
#pragma unroll
        for (int e = 0; e < NE; ++e) lg[e] = 0.f;
#pragma unroll
        for (int j = 0; j < 4; ++j)
#pragma unroll
            for (int cc = 0; cc < 4; ++cc) {
                const float xv = xn[j][cc]; const f32x4* w4 = (const f32x4*)(wr + (size_t)(4 * (lane + 64 * j) + cc) * NE);
#pragma unroll
                for (int q = 0; q < 4; ++q) { const f32x4 w = w4[q]; lg[4 * q] += xv * w.x; lg[4 * q + 1] += xv * w.y; lg[4 * q + 2] += xv * w.z; lg[4 * q + 3] += xv * w.w; }
            }
        float mx = -1e30f;
#pragma unroll
        for (int e = 0; e < NE; ++e) { lg[e] = wave_sum(lg[e]) + br[e]; mx = fmaxf(mx, lg[e]); }
        float sum = 0.f;
#pragma unroll
        for (int e = 0; e < NE; ++e) { lg[e] = __expf(lg[e] - mx); sum += lg[e]; }
        const float inv = 1.f / sum; float mine = 0.f;
#pragma unroll
        for (int e = 0; e < NE; ++e) mine = (lane == e) ? lg[e] * inv : mine;
        if (lane < NE) AFF[(size_t)t * NE + lane] = mine;
    }
}

__device__ __forceinline__ void phase_topk(const Params& p, const Ctx& c0) {
    const Ctx c = launder(c0);
    const float* AFF = (const float*)(p.ws + WS_AFF); int* IDX = (int*)(p.ws + WS_IDX); int* INV = (int*)(p.ws + WS_INV);
    unsigned* hist = (unsigned*)c.lds; unsigned* sh = hist + 256;
    const int tid = c.tid;
    for (int pb = c.bid; pb < BATCH * NE; pb += c.G) {
        const int b = pb / NE, e = pb % NE;
        unsigned key[32];
#pragma unroll
        for (int i = 0; i < 32; ++i) key[i] = __float_as_uint(AFF[(size_t)(b * SEQ + i * 512 + tid) * NE + e]);
        unsigned prefix = 0u, mask = 0u; unsigned kr = CAP;
#pragma unroll 1
        for (int pass = 0; pass < 4; ++pass) {
            const int shift = 24 - 8 * pass;
            __syncthreads();
            if (tid < 256) hist[tid] = 0u;
            __syncthreads();
#pragma unroll
            for (int i = 0; i < 32; ++i) if ((key[i] & mask) == prefix) atomicAdd(&hist[(key[i] >> shift) & 255u], 1u);
            __syncthreads();
            if (tid < 64) {
                const unsigned c0 = hist[4 * tid], c1 = hist[4 * tid + 1], c2 = hist[4 * tid + 2], c3 = hist[4 * tid + 3];
                const unsigned tot = c0 + c1 + c2 + c3; unsigned incl = tot;
#pragma unroll
                for (int o = 1; o < 64; o <<= 1) { const unsigned v = __shfl_down(incl, o); if (tid + o < 64) incl += v; }
                unsigned cum = incl - tot;
                const unsigned cs[4] = {c3, c2, c1, c0};
#pragma unroll
                for (int q = 0; q < 4; ++q) { if (cum < kr && cum + cs[q] >= kr) { sh[0] = prefix | ((unsigned)(4 * tid + 3 - q) << shift); sh[1] = kr - cum; } cum += cs[q]; }
            }
            __syncthreads();
            prefix = sh[0]; kr = sh[1]; mask |= 0xFFu << shift;
        }
        const unsigned thr = prefix; const unsigned n_gt = CAP - kr;
        __syncthreads();
        if (tid == 0) { sh[2] = 0u; sh[3] = 0u; sh[4] = 0u; }
        __syncthreads();
        unsigned myeq = 0u;
#pragma unroll
        for (int i = 0; i < 32; ++i) myeq += (key[i] == thr) ? 1u : 0u;
        if (myeq) atomicAdd(&sh[4], myeq);
        __syncthreads();
        const bool fast = (sh[4] == kr);
#pragma unroll
        for (int i = 0; i < 32; ++i) {
            const int t = i * 512 + tid; const unsigned k = key[i]; int slot = -1;
            if (k > thr) slot = (int)atomicAdd(&sh[2], 1u);
            else if (k == thr && fast) slot = (int)(n_gt + atomicAdd(&sh[3], 1u));
            if (k != thr || fast) { INV[(size_t)(b * SEQ + t) * NE + e] = slot; if (slot >= 0) IDX[pb * CAP + slot] = t; }
        }
        if (!fast && tid == 0) {
            unsigned cnt = 0u;
            for (int t = 0; t < SEQ; ++t) {
                if (__float_as_uint(AFF[(size_t)(b * SEQ + t) * NE + e]) == thr) {
                    int slot = -1; if (cnt < kr) { slot = (int)(n_gt + cnt); ++cnt; }
                    INV[(size_t)(b * SEQ + t) * NE + e] = slot; if (slot >= 0) IDX[pb * CAP + slot] = t;
                }
            }
        }
        __syncthreads();
    }
}

__device__ __forceinline__ void phase_moe1(const Params& p, const Ctx& c0, int l) {
    const Ctx c = launder(c0);
    const int* IDX = (const int*)(p.ws + WS_IDX); bf16* HID = (bf16*)(p.ws + WS_HID);
    constexpr int TPP = (CAP / 64) * (FF / 128);
    for (int ft = c.bid; ft < BATCH * NE * TPP; ft += c.G) {
        const int pb = ft / TPP, lt = ft % TPP, b = pb / NE, e = pb % NE;
        NGemm g{(const bf16*)(p.ws + WS_HN), DM, IDX + pb * CAP, b * SEQ, p.in[I_WG] + ((size_t)l * NE + e) * DM * FF, p.in[I_WU] + ((size_t)l * NE + e) * DM * FF, FF, FF, DM};
        bf16* hp = HID + (size_t)pb * CAP * FF;
        ngemm_tile<true>(g, lt / (FF / 128), lt % (FF / 128), c.lds, [=](int r, int col, const float (&v)[4], const float (&u)[4]) {
            float h[4];
#pragma unroll
            for (int i = 0; i < 4; ++i) h[i] = v[i] / (1.f + __expf(-v[i])) * u[i];
            u32x2 w; w.x = pk2(h[0], h[1]); w.y = pk2(h[2], h[3]); *(u32x2*)(hp + (size_t)r * FF + col) = w; });
    }
}
__device__ __forceinline__ void phase_moe2(const Params& p, const Ctx& c0, int l) {
    const Ctx c = launder(c0);
    bf16* YS = (bf16*)(p.ws + WS_YS);
    constexpr int TPP = (CAP / 128) * (DM / 128);
    for (int ft = c.bid; ft < BATCH * NE * TPP; ft += c.G) {
        const int pb = ft / TPP, lt = ft % TPP, e = pb % NE;
        NGemm g{(const bf16*)(p.ws + WS_HID) + (size_t)pb * CAP * FF, FF, nullptr, 0, p.in[I_WD] + ((size_t)l * NE + e) * FF * DM, nullptr, DM, DM, FF};
        bf16* yp = YS + (size_t)pb * CAP * DM;
        ngemm_tile<false>(g, lt / (DM / 128), lt % (DM / 128), c.lds, [=](int r, int col, const float (&v)[4], const float (&)[4]) {
            u32x2 w; w.x = pk2(v[0], v[1]); w.y = pk2(v[2], v[3]); *(u32x2*)(yp + (size_t)r * DM + col) = w; });
    }
}
__device__ __forceinline__ void phase_combine(const Params& p, const Ctx& c0, int l) {
    const Ctx c = launder(c0);
    const float* AFF = (const float*)(p.ws + WS_AFF); const int* INV = (const int*)(p.ws + WS_INV); const bf16* YS = (const bf16*)(p.ws + WS_YS);
    bf16* HN = (bf16*)(p.ws + WS_HN); const int lane = c.lane;
    for (int t = c.gw; t < T; t += c.ngw) {
        const int b = t / SEQ;
        f32x4 v[4]; row_load(p.out + (size_t)t * DM, lane, v);
        const int myslot = lane < NE ? INV[(size_t)t * NE + lane] : -1; const float myg = lane < NE ? AFF[(size_t)t * NE + lane] : 0.f;
#pragma unroll 1
        for (int e = 0; e < NE; ++e) {
            const int slot = __shfl(myslot, e); const float gt = __shfl(myg, e);
            if (slot >= 0) {
                const bf16* yr = YS + ((size_t)(b * NE + e) * CAP + slot) * DM;
#pragma unroll
                for (int j = 0; j < 4; ++j) { const u32x2 w = *(const u32x2*)(yr + 4 * (lane + 64 * j));
                    v[j].x += gt * bflo(w.x); v[j].y += gt * bfhi(w.x); v[j].z += gt * bflo(w.y); v[j].w += gt * bfhi(w.y); }
            }
        }
#pragma unroll
        for (int j = 0; j < 4; ++j) *(f32x4*)(p.out + (size_t)t * DM + 4 * (lane + 64 * j)) = v[j];
        if (l + 1 < DEPTH) { f32x4 xn[4]; const float rstd = row_rstd(v); row_norm_store(v, rstd, p.in[I_NORM_MIX] + (l + 1) * DM, HN + (size_t)t * DM, lane, xn); }
    }
}

namespace pg8 {
typedef short bf16x8 __attribute__((ext_vector_type(8)));
constexpr int BM = 256, BK = 64, HALF = 128, HTB = HALF * BK * 2, STAGE_BYTES = 8 * HTB, NXCD = 8, WGM = 8;
__host__ __device__ __forceinline__ int lds_byte(int r, int c) { const int st = (r >> 4) * 2 + (c >> 5), rr = r & 15, cc = c & 31, ob = rr * 64 + cc * 2; return st * 1024 + (ob ^ (((ob >> 9) & 1) << 5)); }
__host__ __device__ __forceinline__ void stage_rc(int b, int& R, int& C) { const int st = b / 1024, sb = b % 1024, swz = sb ^ (((sb >> 9) & 1) << 5); R = (st >> 1) * 16 + swz / 64; C = (st & 1) * 32 + (swz % 64) / 2; }
__host__ __device__ __forceinline__ int perm32(int rho) { const int n = rho >> 4, i = rho & 15; return 8 * (i >> 2) + 4 * n + (i & 3); }
struct Unit { int pm, pn; };
struct Gemm { const bf16* A; const bf16* Bt; int lda; int K; const int* rows; };
struct StaticOrder {
    int nM, nN, nwg, G, c;
    __device__ void init(int M, int N, int G_, int c_) { nM = M / BM; nN = N / BM; nwg = nM * nN; G = G_; c = c_; }
    __device__ bool next(int i, Unit& u) const {
        const long L = (long)i * G + c; if (L >= nwg) return false;
        int wgid = (int)L; { const int q = nwg / NXCD, r = nwg % NXCD, xcd = wgid % NXCD, off = wgid / NXCD; wgid = (xcd < r ? xcd * (q + 1) : r * (q + 1) + (xcd - r) * q) + off; }
        const int nig = WGM * nN, gid = wgid / nig, fm = gid * WGM, gsz = (nM - fm) < WGM ? (nM - fm) : WGM;
        u.pm = fm + ((wgid % nig) % gsz); u.pn = (wgid % nig) / gsz; return true;
    }
};
template <int NT> struct GroupedOrder {
    int G, c;
    __device__ bool next(int i, Unit& u) const {
        constexpr int UPP = 8 * NT, NU = BATCH * NE * UPP;
        int pb, pm, pn;
        if (G == 256 && NT == 8) { if (i >= NU / 256) return false; const int x = c & 7, j = c >> 3; pb = i * 4 + (x >> 1); pm = (x & 1) * 4 + (j >> 3); pn = j & 7; }
        else if (G == 256 && NT == 4) { if (i >= NU / 256) return false; const int x = c & 7, j = c >> 3; pb = i * 8 + x; pm = j >> 2; pn = j & 3; }
        else { const long L = (long)i * G + c; if (L >= NU) return false; pb = (int)(L / UPP); const int r = (int)(L % UPP); pm = r / NT; pn = r % NT; }
        u.pm = pb * 8 + pm; u.pn = (pb % NE) * NT + pn; return true;
    }
};
__device__ __forceinline__ unsigned cvt_pk_bf16(float lo, float hi) { unsigned r; asm volatile("v_cvt_pk_bf16_f32 %0, %1, %2" : "=v"(r) : "v"(lo), "v"(hi)); return r; }
struct EpiBf16 {
    static constexpr bool PERM = true;
    bf16* O; int ldc; int ncols; int pn_mod;
    __device__ __forceinline__ void operator()(const f32x4 (&acc)[2][2][4][2], const Unit& u, int wr, int wc, int fr, int fq) const {
        const int row0 = u.pm * BM + wr * 64 + fr, col0 = (pn_mod ? u.pn % pn_mod : u.pn) * BM + wc * 32 + 8 * fq;
#pragma unroll
        for (int ai = 0; ai < 2; ++ai)
#pragma unroll
            for (int m = 0; m < 4; ++m) { bf16* rowp = O + (size_t)(row0 + ai * HALF + m * 16) * ldc + col0;
#pragma unroll
                for (int bj = 0; bj < 2; ++bj) { const f32x4 v0 = acc[ai][bj][m][0], v1 = acc[ai][bj][m][1];
                    u32x4 w; w.x = cvt_pk_bf16(v0[0], v0[1]); w.y = cvt_pk_bf16(v0[2], v0[3]); w.z = cvt_pk_bf16(v1[0], v1[1]); w.w = cvt_pk_bf16(v1[2], v1[3]);
                    if (col0 + bj * HALF < ncols) *(u32x4*)(rowp + bj * HALF) = w; } }
    }
};
struct EpiSwiglu {
    static constexpr bool PERM = true;
    bf16* O;
    __device__ __forceinline__ void operator()(const f32x4 (&acc)[2][2][4][2], const Unit& u, int wr, int wc, int fr, int fq) const {
        const int row0 = u.pm * BM + wr * 64 + fr, col0 = (u.pn & 7) * HALF + wc * 32 + 8 * fq;
#pragma unroll
        for (int ai = 0; ai < 2; ++ai)
#pragma unroll
            for (int m = 0; m < 4; ++m) { float h[8];
#pragma unroll
                for (int n = 0; n < 2; ++n)
#pragma unroll
                    for (int j = 0; j < 4; ++j) { const float g = acc[ai][0][m][n][j], up = acc[ai][1][m][n][j]; h[4 * n + j] = g * __builtin_amdgcn_rcpf(1.f + __expf(-g)) * up; }
                u32x4 w; w.x = cvt_pk_bf16(h[0], h[1]); w.y = cvt_pk_bf16(h[2], h[3]); w.z = cvt_pk_bf16(h[4], h[5]); w.w = cvt_pk_bf16(h[6], h[7]);
                *(u32x4*)(O + (size_t)(row0 + ai * HALF + m * 16) * FF + col0) = w; }
    }
};
struct EpiResF32 {
    static constexpr bool PERM = false;
    const float* res; float* out; int ldc;
    __device__ __forceinline__ void operator()(const f32x4 (&acc)[2][2][4][2], const Unit& u, int wr, int wc, int fr, int fq) const {
        const int col0 = u.pn * BM + wc * 32 + 4 * fq;
#pragma unroll
        for (int ai = 0; ai < 2; ++ai)
#pragma unroll
            for (int m = 0; m < 4; ++m) { const size_t off = (size_t)(u.pm * BM + ai * HALF + wr * 64 + m * 16 + fr) * ldc + col0;
#pragma unroll
                for (int bj = 0; bj < 2; ++bj)
#pragma unroll
                    for (int n = 0; n < 2; ++n) { const f32x4 r = *(const f32x4*)(res + off + bj * HALF + n * 16); *(f32x4*)(out + off + bj * HALF + n * 16) = r + acc[ai][bj][m][n]; } }
    }
};
template <class Epi, class Sched, bool ALIGN_EPI>
__device__ __forceinline__ void gemm_phase(LAS unsigned char* lds, const Gemm g, const Sched& S, const Epi& E) {
    const int tid = threadIdx.x, wid = __builtin_amdgcn_readfirstlane(tid >> 6), lane = tid & 63, wr = wid >> 2, wc = wid & 3, fr = lane & 15, fq = lane >> 4;
    const int K = g.K, nt = K / BK;
    int RA[2], CA[2]; unsigned voffB[2];
#pragma unroll
    for (int i = 0; i < 2; ++i) { int R, C; stage_rc(tid * 16 + i * 8192, R, C); const int Rb = Epi::PERM ? ((R & ~31) + perm32(R & 31)) : R; RA[i] = R; CA[i] = C; voffB[i] = (unsigned)(Rb * K + C) * 2u; }
    const size_t kstep = (size_t)(BK * 2), hstepB = (size_t)HALF * K * 2, tstepB = 2 * hstepB;
    const unsigned ldsw = (unsigned)wid * 1024u;
    const int aoff = lds_byte(wr * 64 + fr, fq * 8), boff = lds_byte(wc * 32 + fr, fq * 8);
#define PG8_AOFFS(dst, pm_) do { _Pragma("unroll") for (int h_ = 0; h_ < 2; ++h_) _Pragma("unroll") for (int i_ = 0; i_ < 2; ++i_) { const int row_ = (pm_) * BM + h_ * HALF + RA[i_]; \
        const int arow_ = g.rows ? ((row_ >> 15) * SEQ + g.rows[row_]) : row_; dst[h_][i_] = (unsigned)(arow_ * g.lda + CA[i_]) * 2u; } } while (0)
#define PG8_SA(b, h) (((b) * 2 + (h)) * HTB)
#define PG8_SB(b, h) ((4 + (b) * 2 + (h)) * HTB)
#define PG8_STAGE_B(bufoff, gbase) do { _Pragma("unroll") for (int _i = 0; _i < 2; ++_i) \
        __builtin_amdgcn_global_load_lds((const unsigned*)((const char*)(gbase) + voffB[_i]), (LAS unsigned*)(lds + (bufoff) + ldsw + _i * 8192), 16, 0, 0); } while (0)
#define PG8_STAGE_A(bufoff, o0, o1, kb) do { \
        __builtin_amdgcn_global_load_lds((const unsigned*)((const char*)g.A + (kb) + (o0)), (LAS unsigned*)(lds + (bufoff) + ldsw), 16, 0, 0); \
        __builtin_amdgcn_global_load_lds((const unsigned*)((const char*)g.A + (kb) + (o1)), (LAS unsigned*)(lds + (bufoff) + ldsw + 8192), 16, 0, 0); } while (0)
#define PG8_LDA(dst, b, h) do { _Pragma("unroll") for (int m = 0; m < 4; ++m) _Pragma("unroll") for (int k = 0; k < 2; ++k) dst[m][k] = *(const LAS bf16x8*)(lds + PG8_SA(b, h) + aoff + m * 2048 + k * 1024); } while (0)
#define PG8_LDB(dst, b, h) do { _Pragma("unroll") for (int n = 0; n < 2; ++n) _Pragma("unroll") for (int k = 0; k < 2; ++k) dst[n][k] = *(const LAS bf16x8*)(lds + PG8_SB(b, h) + boff + n * 2048 + k * 1024); } while (0)
#define PG8_MMA(ai, bj, At, Bt) do { __builtin_amdgcn_s_setprio(1); _Pragma("unroll") for (int m = 0; m < 4; ++m) _Pragma("unroll") for (int n = 0; n < 2; ++n) _Pragma("unroll") for (int k = 0; k < 2; ++k) \
        acc[ai][bj][m][n] = __builtin_amdgcn_mfma_f32_16x16x32_bf16(Bt[n][k], At[m][k], acc[ai][bj][m][n], 0, 0, 0); __builtin_amdgcn_s_setprio(0); } while (0)
#define PG8_WAIT_V(n) asm volatile("s_waitcnt vmcnt(" #n ")" ::: "memory")
#define PG8_WAIT_L(n) asm volatile("s_waitcnt lgkmcnt(" #n ")" ::: "memory")
#define PG8_BAR __builtin_amdgcn_s_barrier()
#define PG8_SCHED __builtin_amdgcn_sched_barrier(0)
    Unit cur, nxt; int ui = 0;
    if (!S.next(0, cur)) return;
    f32x4 acc[2][2][4][2];
#pragma unroll
    for (int a = 0; a < 2; ++a)
#pragma unroll
        for (int b = 0; b < 2; ++b)
#pragma unroll
            for (int m = 0; m < 4; ++m)
#pragma unroll
                for (int n = 0; n < 2; ++n) acc[a][b][m][n] = (f32x4){0.f, 0.f, 0.f, 0.f};
    bf16x8 At[4][2], B0[2][2], B1[2][2];
    unsigned ao[2][2], nao[2][2];
    PG8_AOFFS(ao, cur.pm);
    const char* cB = (const char*)g.Bt + (size_t)cur.pn * tstepB;
    PG8_STAGE_B(PG8_SB(0, 0), cB); PG8_STAGE_B(PG8_SB(0, 1), cB + hstepB); PG8_STAGE_A(PG8_SA(0, 0), ao[0][0], ao[0][1], 0u); PG8_STAGE_A(PG8_SA(0, 1), ao[1][0], ao[1][1], 0u);
    if (wr == 1) PG8_BAR;
    PG8_WAIT_V(2); PG8_BAR;
    PG8_STAGE_B(PG8_SB(1, 0), cB + kstep); PG8_STAGE_A(PG8_SA(1, 0), ao[0][0], ao[0][1], (unsigned)kstep); PG8_STAGE_B(PG8_SB(1, 1), cB + hstepB + kstep);
    PG8_WAIT_V(6); PG8_BAR;
    for (;;) {
        const bool has_next = S.next(ui + 1, nxt);
        const char* nB = has_next ? (const char*)g.Bt + (size_t)nxt.pn * tstepB : cB;
        if (has_next) { PG8_AOFFS(nao, nxt.pm); } else {
#pragma unroll
            for (int h_ = 0; h_ < 2; ++h_)
#pragma unroll
                for (int i_ = 0; i_ < 2; ++i_) nao[h_][i_] = ao[h_][i_]; }
        for (int t = 0; t < nt; t += 2) {
            const bool last = (t == nt - 2);
            const unsigned k1 = (unsigned)(t + 1) * (unsigned)kstep;
            const unsigned k2 = last ? 0u : (unsigned)(t + 2) * (unsigned)kstep, k3 = k2 + (unsigned)kstep;
            const unsigned o200 = last ? nao[0][0] : ao[0][0], o201 = last ? nao[0][1] : ao[0][1], o210 = last ? nao[1][0] : ao[1][0], o211 = last ? nao[1][1] : ao[1][1];
            const char* b2 = last ? nB : cB + (size_t)(t + 2) * kstep; const char* b3 = b2 + kstep;
            PG8_LDB(B0, 0, 0); PG8_LDB(B1, 0, 1); PG8_SCHED; PG8_LDA(At, 0, 0); PG8_STAGE_A(PG8_SA(1, 1), ao[1][0], ao[1][1], k1);
            PG8_WAIT_V(8); PG8_WAIT_L(0); PG8_BAR; PG8_MMA(0, 0, At, B0); PG8_MMA(0, 1, At, B1); PG8_BAR; PG8_SCHED;
            PG8_LDA(At, 0, 1); PG8_STAGE_B(PG8_SB(0, 0), b2); PG8_STAGE_B(PG8_SB(0, 1), b2 + hstepB); PG8_STAGE_A(PG8_SA(0, 0), o200, o201, k2);
            PG8_WAIT_V(8); PG8_WAIT_L(0); PG8_BAR; PG8_MMA(1, 0, At, B0); PG8_MMA(1, 1, At, B1); PG8_BAR; PG8_SCHED;
            PG8_LDB(B0, 1, 0); PG8_LDB(B1, 1, 1); PG8_SCHED; PG8_LDA(At, 1, 0); PG8_STAGE_A(PG8_SA(0, 1), o210, o211, k2);
            PG8_WAIT_V(8); PG8_WAIT_L(0); PG8_BAR; PG8_MMA(0, 0, At, B0); PG8_MMA(0, 1, At, B1); PG8_BAR; PG8_SCHED;
            PG8_LDA(At, 1, 1); PG8_STAGE_B(PG8_SB(1, 0), b3); PG8_STAGE_B(PG8_SB(1, 1), b3 + hstepB); PG8_STAGE_A(PG8_SA(1, 0), o200, o201, k3);
            PG8_WAIT_V(8); PG8_WAIT_L(0); PG8_BAR; PG8_MMA(1, 0, At, B0); PG8_MMA(1, 1, At, B1); PG8_BAR; PG8_SCHED;
        }
        if constexpr (ALIGN_EPI) { if (wr == 0) PG8_BAR; }
        E(acc, cur, wr, wc, fr, fq);
        if (!has_next) break;
#pragma unroll
        for (int a = 0; a < 2; ++a)
#pragma unroll
            for (int b = 0; b < 2; ++b)
#pragma unroll
                for (int m = 0; m < 4; ++m)
#pragma unroll
                    for (int n = 0; n < 2; ++n) acc[a][b][m][n] = (f32x4){0.f, 0.f, 0.f, 0.f};
        cur = nxt; cB = nB; ++ui;
#pragma unroll
        for (int h_ = 0; h_ < 2; ++h_)
#pragma unroll
            for (int i_ = 0; i_ < 2; ++i_) ao[h_][i_] = nao[h_][i_];
        if constexpr (ALIGN_EPI) { if (wr == 1) PG8_BAR; }
    }
    PG8_WAIT_V(0);
    if constexpr (!ALIGN_EPI) { if (wr == 0) PG8_BAR; }
    PG8_BAR;
#undef PG8_AOFFS
#undef PG8_SA
#undef PG8_SB
#undef PG8_STAGE_A
#undef PG8_STAGE_B
#undef PG8_LDA
#undef PG8_LDB
#undef PG8_MMA
#undef PG8_WAIT_V
#undef PG8_WAIT_L
#undef PG8_BAR
#undef PG8_SCHED
}
}

constexpr int NIN_PAD = 2560, NUQ_PAD = 768;
constexpr size_t WS_WIN_T = WS_WSMALL, WS_WUQ_T = WS_WSMALL + 10 * MiB, WS_WUKV_T = WS_WUQ_T + 2 * (size_t)NUQ_PAD * QR * 2, WS_WOUT_T = WS_WSMALL + 12 * MiB;
static_assert(WS_WUKV_T + 2 * (size_t)768 * KVR * 2 <= WS_WOUT_T && WS_WOUT_T + 2 * (size_t)DM * DM * 2 <= WS_WEGU, "small-weight map");
__device__ __forceinline__ void transpose_item(const float* W, int ldw, int K, bf16* WT, int k0, int n0, int drow0, LAS float* scr, int lane) {
#pragma unroll 8
    for (int i = 0; i < 32; ++i) { const int kk = 2 * i + (lane >> 5); scr[kk * 33 + (lane & 31)] = W[(size_t)(k0 + kk) * ldw + n0 + (lane & 31)]; }
    asm volatile("s_waitcnt lgkmcnt(0)" ::: "memory");
    const int cch = lane & 7;
#pragma unroll
    for (int j = 0; j < 4; ++j) { const int n = (lane >> 3) + 8 * j; const LAS float* sp = scr + (8 * cch) * 33 + n;
        u32x4 o; o.x = pk2(sp[0 * 33], sp[1 * 33]); o.y = pk2(sp[2 * 33], sp[3 * 33]); o.z = pk2(sp[4 * 33], sp[5 * 33]); o.w = pk2(sp[6 * 33], sp[7 * 33]);
        *(u32x4*)(WT + (size_t)(drow0 + n) * K + k0 + 8 * cch) = o; }
    asm volatile("s_waitcnt lgkmcnt(0)" ::: "memory");
}
__device__ __forceinline__ void phase_wconv_small(const Params& p, const Ctx& c0) {
    const Ctx c = launder(c0);
    LAS float* scr = (LAS float*)((LAS unsigned char*)c.lds + c.wave * 8704);
    constexpr int I_IN = (DM / 64) * (INC / 32), I_UQ = (QR / 64) * (MH * DQK / 32), I_UKV = (KVR / 64) * (MH * 128 / 32), I_OUT = (DM / 64) * (DM / 32), I_L = I_IN + I_UQ + I_UKV + I_OUT;
    for (int it = c.gw; it < DEPTH * I_L; it += c.ngw) {
        const int l = it / I_L; int r = it % I_L;
        if (r < I_IN) { const int nb = INC / 32; transpose_item(p.in[I_W_IN] + (size_t)l * DM * INC, INC, DM, (bf16*)(p.ws + WS_WIN_T) + (size_t)l * NIN_PAD * DM, 64 * (r / nb), 32 * (r % nb), 32 * (r % nb), scr, c.lane); continue; } r -= I_IN;
        if (r < I_UQ) { const int nb = MH * DQK / 32; transpose_item(p.in[I_WUQ] + (size_t)l * QR * MH * DQK, MH * DQK, QR, (bf16*)(p.ws + WS_WUQ_T) + (size_t)l * NUQ_PAD * QR, 64 * (r / nb), 32 * (r % nb), 32 * (r % nb), scr, c.lane); continue; } r -= I_UQ;
        if (r < I_UKV) { const int nb = MH * 128 / 32; transpose_item(p.in[I_WUKV] + (size_t)l * KVR * MH * 128, MH * 128, KVR, (bf16*)(p.ws + WS_WUKV_T) + (size_t)l * 768 * KVR, 64 * (r / nb), 32 * (r % nb), 32 * (r % nb), scr, c.lane); continue; } r -= I_UKV;
        { const int nb = DM / 32; transpose_item(p.in[I_WOUT] + (size_t)l * DM * DM, DM, DM, (bf16*)(p.ws + WS_WOUT_T) + (size_t)l * DM * DM, 64 * (r / nb), 32 * (r % nb), 32 * (r % nb), scr, c.lane); }
    }
    constexpr int Z_IN = (NIN_PAD - INC) * DM / 8, Z_UQ = (NUQ_PAD - MH * DQK) * QR / 8;
    for (int it = c.bid * 512 + c.tid; it < DEPTH * (Z_IN + Z_UQ); it += c.G * 512) {
        const int l = it / (Z_IN + Z_UQ), r = it % (Z_IN + Z_UQ);
        u32x4* dst = r < Z_IN ? (u32x4*)((bf16*)(p.ws + WS_WIN_T) + (size_t)l * NIN_PAD * DM + (size_t)INC * DM) + r : (u32x4*)((bf16*)(p.ws + WS_WUQ_T) + (size_t)l * NUQ_PAD * QR + (size_t)MH * DQK * QR) + (r - Z_IN);
        *dst = (u32x4){0u, 0u, 0u, 0u};
    }
}
__device__ __forceinline__ void phase_wconv_experts(const Params& p, const Ctx& c0, int l) {
    const Ctx c = launder(c0);
    LAS float* scr = (LAS float*)((LAS unsigned char*)c.lds + c.wave * 8704);
    constexpr int I_M = (DM / 64) * (FF / 32);
    bf16* WGU = (bf16*)(p.ws + WS_WEGU); bf16* WD = (bf16*)(p.ws + WS_WED);
    for (int it = c.gw; it < NE * 3 * I_M; it += c.ngw) {
        const int e = it / (3 * I_M), which = (it / I_M) % 3, r = it % I_M, k0 = 64 * (r / 32), n0 = 32 * (r % 32);
        const size_t woff = ((size_t)l * NE + e) * DM * FF;
        if (which == 0) transpose_item(p.in[I_WG] + woff, FF, DM, WGU + (size_t)e * 2048 * DM, k0, n0, (n0 >> 7) * 256 + (n0 & 127), scr, c.lane);
        else if (which == 1) transpose_item(p.in[I_WU] + woff, FF, DM, WGU + (size_t)e * 2048 * DM, k0, n0, (n0 >> 7) * 256 + 128 + (n0 & 127), scr, c.lane);
        else transpose_item(p.in[I_WD] + woff, DM, FF, WD + (size_t)e * DM * FF, k0, n0, n0, scr, c.lane);
    }
}

__device__ __forceinline__ void phase_inproj_f(const Params& p, const Ctx& c0, int l) {
    const Ctx c = launder(c0);
    pg8::Gemm g{(const bf16*)(p.ws + WS_HN), (const bf16*)(p.ws + WS_WIN_T) + (size_t)l * NIN_PAD * DM, DM, DM, nullptr};
    pg8::StaticOrder S; S.init(T, NIN_PAD, c.G, c.bid);
    pg8::EpiBf16 E{(bf16*)(p.ws + WS_PROJ), INC, INC, 0};
    pg8::gemm_phase<pg8::EpiBf16, pg8::StaticOrder, true>((LAS unsigned char*)c.lds, g, S, E);
}
__device__ __forceinline__ void phase_c2_f(const Params& p, const Ctx& c0, int l) {
    const Ctx c = launder(c0);
    {
        pg8::Gemm g{(const bf16*)(p.ws + WS_PROJ) + C_CQ, (const bf16*)(p.ws + WS_WUQ_T) + (size_t)l * NUQ_PAD * QR, INC, QR, nullptr};
        pg8::StaticOrder S; S.init(T, NUQ_PAD, c.G, c.bid);
        pg8::EpiBf16 E{(bf16*)(p.ws + WS_QB), MH * DQK, MH * DQK, 0};
        pg8::gemm_phase<pg8::EpiBf16, pg8::StaticOrder, true>((LAS unsigned char*)c.lds, g, S, E);
    }
    {
        pg8::Gemm g{(const bf16*)(p.ws + WS_PROJ) + C_CKV, (const bf16*)(p.ws + WS_WUKV_T) + (size_t)l * 768 * KVR, INC, KVR, nullptr};
        pg8::StaticOrder S; S.init(T, 768, c.G, c.bid);
        pg8::EpiBf16 E{(bf16*)(p.ws + WS_KV), MH * 128, MH * 128, 0};
        pg8::gemm_phase<pg8::EpiBf16, pg8::StaticOrder, true>((LAS unsigned char*)c.lds, g, S, E);
    }
}
__device__ __forceinline__ void phase_wout_f(const Params& p, const Ctx& c0, int l) {
    const Ctx c = launder(c0);
    pg8::Gemm g{(const bf16*)(p.ws + WS_HN), (const bf16*)(p.ws + WS_WOUT_T) + (size_t)l * DM * DM, DM, DM, nullptr};
    pg8::StaticOrder S; S.init(T, DM, c.G, c.bid);
    pg8::EpiResF32 E{l == 0 ? p.in[I_X] : p.out, p.out, DM};
    pg8::gemm_phase<pg8::EpiResF32, pg8::StaticOrder, true>((LAS unsigned char*)c.lds, g, S, E);
}
__device__ __forceinline__ void phase_moe1_f(const Params& p, const Ctx& c0) {
    const Ctx c = launder(c0);
    pg8::Gemm g{(const bf16*)(p.ws + WS_HN), (const bf16*)(p.ws + WS_WEGU), DM, DM, (const int*)(p.ws + WS_IDX)};
    pg8::GroupedOrder<8> S{c.G, c.bid};
    pg8::EpiSwiglu E{(bf16*)(p.ws + WS_HID)};
    pg8::gemm_phase<pg8::EpiSwiglu, pg8::GroupedOrder<8>, true>((LAS unsigned char*)c.lds, g, S, E);
}
__device__ __forceinline__ void phase_moe2_f(const Params& p, const Ctx& c0) {
    const Ctx c = launder(c0);
    pg8::Gemm g{(const bf16*)(p.ws + WS_HID), (const bf16*)(p.ws + WS_WED), FF, FF, nullptr};
    pg8::GroupedOrder<4> S{c.G, c.bid};
    pg8::EpiBf16 E{(bf16*)(p.ws + WS_YS), DM, DM, 4};
    pg8::gemm_phase<pg8::EpiBf16, pg8::GroupedOrder<4>, true>((LAS unsigned char*)c.lds, g, S, E);
}

#ifndef MK_FUSED
#define MK_FUSED 0
#endif
#define MKCTX extern __shared__ __attribute__((aligned(16))) unsigned char lds[]; Ctx c; c.tid = threadIdx.x; c.lane = c.tid & 63; \
    c.wave = __builtin_amdgcn_readfirstlane(c.tid >> 6); c.G = gridDim.x; c.bid = blockIdx.x; c.gw = c.bid * 8 + c.wave; c.ngw = c.G * 8; c.lds = lds;
enum { PH_PRO = 0, PH_INPROJ, PH_C1, PH_C2, PH_C3, PH_ATTN, PH_OUTNORM, PH_WOUT, PH_ROUTER, PH_TOPK, PH_MOE1, PH_MOE2, PH_COMBINE, PH_NA, PH_MLA, PH_WCONVE };
#if !MK_FUSED
template <int PH> __global__ void __launch_bounds__(512, 2) k_phase(Params p, int l) {
    MKCTX
    if (PH == PH_PRO) { phase_rope_table(p, c); phase_norm0(p, c); phase_wconv_small(p, c); }
    if (PH == PH_WCONVE) phase_wconv_experts(p, c, l);
    if (PH == PH_INPROJ) phase_inproj_f(p, c, l);
    if (PH == PH_C1) phase_c1(p, c, l);
    if (PH == PH_C2) phase_c2_f(p, c, l);
    if (PH == PH_C3) phase_c3(p, c, l);
    if (PH == PH_NA) phase_na_simple(p, c, l);
    if (PH == PH_MLA) phase_mla(p, c);
    if (PH == PH_OUTNORM) phase_outnorm(p, c, l);
    if (PH == PH_WOUT) phase_wout_f(p, c, l);
    if (PH == PH_ROUTER) phase_router(p, c, l);
    if (PH == PH_TOPK) phase_topk(p, c);
    if (PH == PH_MOE1) phase_moe1_f(p, c);
    if (PH == PH_MOE2) phase_moe2_f(p, c);
    if (PH == PH_COMBINE) phase_combine(p, c, l);
}
#else
__global__ void __launch_bounds__(512, 2) fwd(Params p) {
    MKCTX
    volatile LAS unsigned* st = (volatile LAS unsigned*)((LAS unsigned char*)lds + LDS_CTL_OFF);
    if (c.tid < 4) st[c.tid] = 0u;
    __syncthreads();
    XcdBarrier bar = xcd_barrier_post((unsigned*)(p.ws + WS_CTL), st);
    phase_rope_table(p, c);
    phase_norm0(p, c);
    xcd_barrier(bar);
#pragma unroll 1
    for (int l = 0; l < DEPTH; ++l) {
        phase_inproj(p, c, l);       xcd_barrier(bar);
        phase_c1(p, c, l);           xcd_barrier(bar);
        phase_c2(p, c, l);           xcd_barrier(bar);
        phase_c3(p, c, l);           xcd_barrier(bar);
        phase_na_simple(p, c, l);
        phase_mla_simple(p, c);      xcd_barrier(bar);
        phase_outnorm(p, c, l);      xcd_barrier(bar);
        phase_wout(p, c, l);         xcd_barrier(bar);
        phase_router(p, c, l);       xcd_barrier(bar);
        phase_topk(p, c);            xcd_barrier(bar);
        phase_moe1(p, c, l);         xcd_barrier(bar);
        phase_moe2(p, c, l);         xcd_barrier(bar);
        phase_combine(p, c, l);      xcd_barrier(bar);
    }
}
#endif

extern "C" void kernel_launch(void* const* d_in, const int* in_sizes, int n_in, void* d_out, int out_size, void* d_ws, size_t ws_size, hipStream_t stream) {
    static int grid = 0;
    if (grid == 0) {
        if (n_in != N_IN || in_sizes[0] != T * DM || out_size != T * DM || ws_size < WS_END) {
            fprintf(stderr, "kernel_launch: shape mismatch n_in %d in0 %d out %d ws %zu (need %zu)\n", n_in, n_in > 0 ? in_sizes[0] : -1, out_size, ws_size, (size_t)WS_END); grid = -1; return; }
        int dev = 0, cus = 0;
        if (hipGetDevice(&dev) != hipSuccess || hipDeviceGetAttribute(&cus, hipDeviceAttributeMultiprocessorCount, dev) != hipSuccess) { grid = -1; return; }
#if MK_FUSED
        if (hipFuncSetAttribute((const void*)fwd, hipFuncAttributeMaxDynamicSharedMemorySize, LDS_BYTES) != hipSuccess) { fprintf(stderr, "kernel_launch: hipFuncSetAttribute failed\n"); grid = -1; return; }
#endif
        grid = cus;
    }
    if (grid < 0) return;
    Params p{};
    for (int i = 0; i < N_IN; ++i) p.in[i] = (const float*)d_in[i];
    p.out = (float*)d_out; p.ws = (unsigned char*)d_ws;
#if MK_FUSED
    if (hipMemsetAsync((char*)d_ws + WS_CTL, 0, CTL_ZERO_BYTES, stream) != hipSuccess) return;
    hipLaunchKernelGGL(fwd, dim3(grid), dim3(512), LDS_BYTES, stream, p);
#else
    constexpr int SL = 131072;
#define LAUNCH(PH, l) do { static bool attr_ = false; if (!attr_) { (void)hipFuncSetAttribute((const void*)k_phase<PH>, hipFuncAttributeMaxDynamicSharedMemorySize, SL); attr_ = true; } \
        hipLaunchKernelGGL(k_phase<PH>, dim3(grid), dim3(512), SL, stream, p, l); } while (0)
    LAUNCH(PH_PRO, 0);
    for (int l = 0; l < DEPTH; ++l) {
        LAUNCH(PH_INPROJ, l); LAUNCH(PH_C1, l); LAUNCH(PH_C2, l); LAUNCH(PH_C3, l); LAUNCH(PH_NA, l); LAUNCH(PH_MLA, l);
        LAUNCH(PH_OUTNORM, l); LAUNCH(PH_WOUT, l); LAUNCH(PH_ROUTER, l); LAUNCH(PH_TOPK, l); LAUNCH(PH_WCONVE, l); LAUNCH(PH_MOE1, l); LAUNCH(PH_MOE2, l); LAUNCH(PH_COMBINE, l);
    }
#endif
    const hipError_t le = hipPeekAtLastError();
    if (le != hipSuccess) fprintf(stderr, "kernel_launch: launch failed: %s\n", hipGetErrorName(le));
}
```
